# Optimizing an MI355X kernel written in HIP

```python
import math
import jax, jax.numpy as jnp
from jax import lax
import numpy as np

D_MODEL = 1024
BATCH = 16
SEQ = 256
DEPTH = 4
DEC_BATCH = 8
DEC_SEQ = 4096
PAST_LEN = 512

GRID_W = 64
N_MIXERS = 2
EXPAND = 2
D_INNER = EXPAND * D_MODEL
N_HEADS = 8
HEAD_DIM = D_INNER // (2 * N_HEADS)
V_DIM = 2 * HEAD_DIM
AXIS_DIM = HEAD_DIM // 2
ROPE_BASE = 10000.0
N_FOURIER_GROUPS = 8
FOURIER_GROUP_DIM = D_INNER // N_FOURIER_GROUPS
N_FOURIER_LAYERS = (DEPTH + 1) // 2
N_ATTN_LAYERS = DEPTH // 2
Q_BLOCK = 128
EPS = 1e-6
LAMBDA_STD = 0.1

kernel_name = 'hybrid_fnet_diffattn_dit_step'


def rms_norm(x, g):
    xf = x.astype(jnp.float32)
    y = xf * lax.rsqrt(jnp.mean(xf * xf, axis=-1, keepdims=True) + EPS)
    return (y * g.astype(jnp.float32)).astype(x.dtype)


def adaln_params(cond, w_ada, b_ada):
    m = jax.nn.silu(cond) @ w_ada + b_ada
    return jnp.split(m, 3, axis=-1)


def axial_rope_tables(n):
    rows = n // GRID_W
    row = jnp.broadcast_to(jnp.arange(rows, dtype=jnp.float32)[:, None], (rows, GRID_W)).reshape(-1)
    col = jnp.broadcast_to(jnp.arange(GRID_W, dtype=jnp.float32)[None, :], (rows, GRID_W)).reshape(-1)
    inv = ROPE_BASE ** (-jnp.arange(0, AXIS_DIM, 2, dtype=jnp.float32) / AXIS_DIM)
    ar = row[:, None] * inv[None, :]
    ac = col[:, None] * inv[None, :]
    ang = jnp.concatenate([ar, ar, ac, ac], axis=-1)
    return jnp.cos(ang), jnp.sin(ang)


def apply_rope(x, cos, sin):
    xr = x.reshape(x.shape[:-1] + (2, 2, AXIS_DIM // 2))
    rot = jnp.stack([-xr[..., 1, :], xr[..., 0, :]], axis=-2).reshape(x.shape)
    c = cos[:, None, None, :].astype(x.dtype)
    s = sin[:, None, None, :].astype(x.dtype)
    return x * c + rot * s


def gated_out(o, g, w_out):
    return (o * jax.nn.silu(g)) @ w_out


def fourier_mix(u):
    b, n, e = u.shape
    ug = u.reshape(b, n, N_FOURIER_GROUPS, FOURIER_GROUP_DIM).astype(jnp.float32)
    f = jnp.fft.fft2(ug, axes=(1, 3), norm='ortho').real
    return f.reshape(b, n, e).astype(u.dtype)


def fourier_layer(h, w_in, w_out):
    u, g = jnp.split(h @ w_in, 2, axis=-1)
    return gated_out(fourier_mix(u), g, w_out)


def attn_project(h, w_in):
    b, n, _ = h.shape
    q, k, v, g = jnp.split(h @ w_in, 4, axis=-1)
    return (q.reshape(b, n, N_HEADS, 2, HEAD_DIM),
            k.reshape(b, n, N_HEADS, 2, HEAD_DIM),
            v.reshape(b, n, N_HEADS, V_DIM),
            g)


def diff_attend(q, k, v, lam):
    b, nq = q.shape[:2]
    qb = min(Q_BLOCK, nq)
    nblk = nq // qb
    qblocks = jnp.moveaxis(q.reshape(b, nblk, qb, N_HEADS, 2, HEAD_DIM), 1, 0)
    scale = HEAD_DIM ** -0.5

    def block(qi):
        s = jnp.einsum('bqhcd,bkhcd->cbhqk', qi, k).astype(jnp.float32) * scale
        p = jax.nn.softmax(s, axis=-1)
        a = (p[0] - lam * p[1]).astype(v.dtype)
        return jnp.einsum('bhqk,bkhv->bqhv', a, v)

    out = lax.map(block, qblocks)
    return jnp.moveaxis(out, 0, 1).reshape(b, nq, N_HEADS, V_DIM)


def diff_head_out(o, g, subln, lam_init, w_out):
    b, n = o.shape[:2]
    o = rms_norm(o, subln) * (1.0 - lam_init)
    return gated_out(o.reshape(b, n, D_INNER), g, w_out)


def setup_inputs(seed: int = 0) -> dict:
    key = jax.random.key(seed)
    ks = jax.random.split(key, 19)
    nrm = jax.random.normal
    f32 = jnp.float32
    return {
        'x_prompt': nrm(ks[0], (BATCH, SEQ, D_MODEL), f32),
        'x_sample': nrm(ks[1], (DEC_BATCH, DEC_SEQ, D_MODEL), f32),
        'cache_k': nrm(ks[2], (DEC_BATCH, N_ATTN_LAYERS, PAST_LEN, N_HEADS, 2 * HEAD_DIM), f32),
        'cache_v': nrm(ks[3], (DEC_BATCH, N_ATTN_LAYERS, PAST_LEN, N_HEADS, V_DIM), f32),
        'c': nrm(ks[4], (DEC_BATCH, D_MODEL), f32),
        'c_ctx': nrm(ks[5], (D_MODEL,), f32),
        'norm_g': 1.0 + 0.01 * nrm(ks[6], (DEPTH, D_MODEL), f32),
        'w_ada': 0.5 * D_MODEL ** -0.5 * nrm(ks[7], (DEPTH, D_MODEL, 3 * D_MODEL), f32),
        'b_ada': 0.01 * nrm(ks[8], (DEPTH, 3 * D_MODEL), f32),
        'w_in_fourier': D_MODEL ** -0.5 * nrm(ks[9], (N_FOURIER_LAYERS, D_MODEL, 2 * D_INNER), f32),
        'w_out_fourier': D_INNER ** -0.5 * nrm(ks[10], (N_FOURIER_LAYERS, D_INNER, D_MODEL), f32),
        'w_in_attn': D_MODEL ** -0.5 * nrm(ks[11], (N_ATTN_LAYERS, D_MODEL, 4 * D_INNER), f32),
        'w_out_attn': D_INNER ** -0.5 * nrm(ks[12], (N_ATTN_LAYERS, D_INNER, D_MODEL), f32),
        'lam_q1': LAMBDA_STD * nrm(ks[13], (N_ATTN_LAYERS, HEAD_DIM), f32),
        'lam_k1': LAMBDA_STD * nrm(ks[14], (N_ATTN_LAYERS, HEAD_DIM), f32),
        'lam_q2': LAMBDA_STD * nrm(ks[15], (N_ATTN_LAYERS, HEAD_DIM), f32),
        'lam_k2': LAMBDA_STD * nrm(ks[16], (N_ATTN_LAYERS, HEAD_DIM), f32),
        'subln_g': 1.0 + 0.01 * nrm(ks[17], (N_ATTN_LAYERS, V_DIM), f32),
        'final_norm_g': 1.0 + 0.01 * nrm(ks[18], (D_MODEL,), f32),
    }


def reference(x_prompt, x_sample, cache_k, cache_v, c, c_ctx, norm_g, w_ada, b_ada,
              w_in_fourier, w_out_fourier, w_in_attn, w_out_attn,
              lam_q1, lam_k1, lam_q2, lam_k2, subln_g, final_norm_g):
    dec_b, n_lat = x_sample.shape[:2]
    past_len = cache_k.shape[2]
    cos, sin = axial_rope_tables(n_lat)
    xp, xs = x_prompt, x_sample
    new_k, new_v = [], []
    for i in range(DEPTH):
        sh_p, sc_p, gt_p = adaln_params(c_ctx, w_ada[i], b_ada[i])
        sh_s, sc_s, gt_s = adaln_params(c, w_ada[i], b_ada[i])
        sh_s, sc_s, gt_s = sh_s[:, None, :], sc_s[:, None, :], gt_s[:, None, :]
        hp = rms_norm(xp, norm_g[i]) * (1.0 + sc_p) + sh_p
        hs = rms_norm(xs, norm_g[i]) * (1.0 + sc_s) + sh_s
        j = i // N_MIXERS
        if i % N_MIXERS == 0:
            op = fourier_layer(hp, w_in_fourier[j], w_out_fourier[j])
            os_ = fourier_layer(hs, w_in_fourier[j], w_out_fourier[j])
        else:
            lam_init = 0.8 - 0.6 * math.exp(-0.3 * i)
            lam = (jnp.exp(jnp.sum(lam_q1[j].astype(jnp.float32) * lam_k1[j].astype(jnp.float32)))
                   - jnp.exp(jnp.sum(lam_q2[j].astype(jnp.float32) * lam_k2[j].astype(jnp.float32)))
                   + lam_init)
            qp, kp, vp, gp = attn_project(hp, w_in_attn[j])
            op = diff_head_out(diff_attend(qp, kp, vp, lam), gp, subln_g[j], lam_init, w_out_attn[j])
            new_k.append(kp.reshape(kp.shape[:2] + (N_HEADS, 2 * HEAD_DIM)))
            new_v.append(vp)
            qs, ks_, vs, gs = attn_project(hs, w_in_attn[j])
            qs = apply_rope(qs, cos, sin)
            ks_ = apply_rope(ks_, cos, sin)
            k_ctx = cache_k[:, j].reshape(dec_b, past_len, N_HEADS, 2, HEAD_DIM)
            k_all = jnp.concatenate([ks_, k_ctx], axis=1)
            v_all = jnp.concatenate([vs, cache_v[:, j]], axis=1)
            os_ = diff_head_out(diff_attend(qs, k_all, v_all, lam), gs, subln_g[j], lam_init, w_out_attn[j])
        xp = xp + gt_p * op
        xs = xs + gt_s * os_
    y_prompt = rms_norm(xp, final_norm_g)
    y_sample = rms_norm(xs, final_norm_g)
    new_cache_k = jnp.stack(new_k, axis=1)
    new_cache_v = jnp.stack(new_v, axis=1)
    return (y_prompt, y_sample, new_cache_k, new_cache_v)
```

```cpp
#include <hip/hip_runtime.h>
#include <hip/hip_cooperative_groups.h>
#include <cstdio>
#include <cstdint>
namespace cg = cooperative_groups;

#define DEVI __device__ __forceinline__
#define LAS __attribute__((address_space(3)))
typedef unsigned short bf16_t;
typedef short bf16x8 __attribute__((ext_vector_type(8)));
typedef short s16x4 __attribute__((ext_vector_type(4)));
typedef float f32x4 __attribute__((ext_vector_type(4)));
typedef float f32x8 __attribute__((ext_vector_type(8)));
typedef float f32x16 __attribute__((ext_vector_type(16)));
typedef unsigned u32x4 __attribute__((ext_vector_type(4)));
typedef unsigned u32x2 __attribute__((ext_vector_type(2)));

constexpr int TP = 4096, TSMP = 32768, TT = 36864;
constexpr int NTHREADS = 512;
constexpr int XB_ST_OFF = 133120;
constexpr int LDS_BYTES = 133136;
constexpr size_t MiB = (size_t)1 << 20;
constexpr size_t WS_MOD = 0;
constexpr size_t WS_LAM = 448 * 1024;
constexpr size_t WS_COS = 452 * 1024;
constexpr size_t WS_SIN = 460 * 1024;
constexpr size_t WS_XBAR = 472 * 1024;
constexpr size_t WS_D256 = 512 * 1024;
constexpr size_t WS_DC256 = 768 * 1024;
constexpr size_t WS_DF512 = 1 * MiB;
constexpr size_t WS_W = 2 * MiB;
constexpr size_t WS_WG = WS_W;
constexpr size_t WS_WPQ = WS_W + 4 * MiB;
constexpr size_t WS_WUB = WS_W + 12 * MiB;
constexpr size_t WS_WATT = WS_W;
constexpr size_t WS_WOUT = WS_W + 16 * MiB;
constexpr size_t WS_ACT = 26 * MiB;
constexpr size_t F_G = WS_ACT;
constexpr size_t F_HTP = WS_ACT + 360 * MiB;
constexpr size_t F_Y = WS_ACT + 8 * MiB;
constexpr size_t F_H = WS_ACT + 144 * MiB;
constexpr size_t F_HCS = WS_ACT + 216 * MiB;
constexpr size_t A_DIFF = WS_ACT;
constexpr size_t A_H = WS_ACT + 144 * MiB;
constexpr size_t A_Q = WS_ACT + 216 * MiB;
constexpr size_t A_K = WS_ACT + 288 * MiB;
constexpr size_t A_V = WS_ACT + 368 * MiB;
constexpr size_t A_SSQ = WS_ACT + 448 * MiB;
constexpr size_t A_STASH = WS_ACT + 451 * MiB;
constexpr size_t WS_NEED = WS_ACT + 467 * MiB;

struct Params {
    const float *x_prompt, *x_sample, *cache_k, *cache_v, *c, *c_ctx, *norm_g, *w_ada, *b_ada, *w_in_f, *w_out_f, *w_in_a, *w_out_a,
        *lam_q1, *lam_k1, *lam_q2, *lam_k2, *subln_g, *final_g;
    float* out; unsigned char* ws;
};

DEVI int otid(int wv) { unsigned z = 0u; asm volatile("" : "+s"(z));
    int t = (wv << 6) | (int)__builtin_amdgcn_mbcnt_hi(~0u, __builtin_amdgcn_mbcnt_lo(~0u, z)); asm volatile("" : "+v"(t)); return t; }
DEVI float shx(float v, int mask, int lane) { return __int_as_float(__builtin_amdgcn_ds_bpermute(((lane ^ mask) & 63) << 2, __float_as_int(v))); }
DEVI float wave_sum(float v, int lane) { v += shx(v, 32, lane); v += shx(v, 16, lane); v += shx(v, 8, lane); v += shx(v, 4, lane); v += shx(v, 2, lane); v += shx(v, 1, lane); return v; }
DEVI unsigned cvt_pk_bf16(float lo, float hi) { unsigned r; asm volatile("v_cvt_pk_bf16_f32 %0, %1, %2" : "=v"(r) : "v"(lo), "v"(hi)); return r; }
DEVI float bf_lo(unsigned w) { return __uint_as_float(w << 16); }
DEVI float bf_hi(unsigned w) { return __uint_as_float(w & 0xffff0000u); }
DEVI float silu_f(float x) { return x * __builtin_amdgcn_rcpf(1.f + __builtin_amdgcn_exp2f(x * -1.4426950408889634f)); }
DEVI int perm32(int rho) { const int n = rho >> 4, i = rho & 15; return 8 * (i >> 2) + 4 * n + (i & 3); }


namespace pg8 {
constexpr int BM = 256, BK = 64, HALF = 128, HTB = HALF * BK * 2, STAGE_BYTES = 8 * HTB;
DEVI int lds_byte(int r, int c) { const int st = (r >> 4) * 2 + (c >> 5), rr = r & 15, cc = c & 31, ob = rr * 64 + cc * 2; return st * 1024 + (ob ^ (((ob >> 9) & 1) << 5)); }
DEVI void stage_rc(int b, int& R, int& C) { const int st = b / 1024, sb = b % 1024, swz = sb ^ (((sb >> 9) & 1) << 5); R = (st >> 1) * 16 + swz / 64; C = (st & 1) * 32 + (swz % 64) / 2; }
struct Unit { const char* A; const char* B; int pm, pn, b, x; };

template <class Epi, class Sched>
DEVI void gemm_phase(LAS unsigned char* lds, int K, int lda, int ldb, const Sched& S, const Epi& E, int wv) {
    asm volatile("" : "+s"(K), "+s"(lda), "+s"(ldb));
    const int tid = otid(wv), wid = __builtin_amdgcn_readfirstlane(tid >> 6), lane = tid & 63, wr = wid >> 2, wc = wid & 3, fr = lane & 15, fq = lane >> 4;
    const int nt = K / BK;
    unsigned voffA[2], voffB[2];
#pragma unroll
    for (int i = 0; i < 2; ++i) { int R, C; stage_rc(tid * 16 + i * 8192, R, C); voffA[i] = (unsigned)(R * lda + C) * 2u; voffB[i] = (unsigned)(R * ldb + C) * 2u; }
    const size_t kstep = (size_t)(BK * 2);
    const size_t hstepA = (size_t)HALF * lda * 2, hstepB = (size_t)HALF * ldb * 2;
    const unsigned ldsw = (unsigned)wid * 1024u;
    const int aoff = lds_byte(wr * 64 + fr, fq * 8), boff = lds_byte(wc * 32 + fr, fq * 8);
#define PG8_SA(b, h) (((b) * 2 + (h)) * HTB)
#define PG8_SB(b, h) ((4 + (b) * 2 + (h)) * HTB)
#define PG8_STAGE(bufoff, gbase, voff) do { _Pragma("unroll") for (int _i = 0; _i < 2; ++_i) \
        __builtin_amdgcn_global_load_lds((const unsigned*)((const char*)(gbase) + (voff)[_i]), (LAS unsigned*)(lds + (bufoff) + ldsw + _i * 8192), 16, 0, 0); } while (0)
#define PG8_LDA(dst, b, h) do { _Pragma("unroll") for (int m = 0; m < 4; ++m) _Pragma("unroll") for (int k = 0; k < 2; ++k) dst[m][k] = *(const LAS bf16x8*)(lds + PG8_SA(b, h) + aoff + m * 2048 + k * 1024); } while (0)
#define PG8_LDB(dst, b, h) do { _Pragma("unroll") for (int n = 0; n < 2; ++n) _Pragma("unroll") for (int k = 0; k < 2; ++k) dst[n][k] = *(const LAS bf16x8*)(lds + PG8_SB(b, h) + boff + n * 2048 + k * 1024); } while (0)
#define PG8_MMA(ai, bj, At, Bt) do { __builtin_amdgcn_s_setprio(1); _Pragma("unroll") for (int m = 0; m < 4; ++m) _Pragma("unroll") for (int n = 0; n < 2; ++n) _Pragma("unroll") for (int k = 0; k < 2; ++k) \
        acc[ai][bj][m][n] = __builtin_amdgcn_mfma_f32_16x16x32_bf16(Bt[n][k], At[m][k], acc[ai][bj][m][n], 0, 0, 0); __builtin_amdgcn_s_setprio(0); } while (0)
#define PG8_WAIT_V(n) asm volatile("s_waitcnt vmcnt(" #n ")" ::: "memory")
#define PG8_WAIT_L(n) asm volatile("s_waitcnt lgkmcnt(" #n ")" ::: "memory")
#define PG8_BAR __builtin_amdgcn_s_barrier()
#define PG8_SCHED __builtin_amdgcn_sched_barrier(0)
    Unit cur, nxt; int ui = 0;
    if (!S.next(0, cur)) return;
    f32x4 acc[2][2][4][2];
#pragma unroll
    for (int a = 0; a < 2; ++a)
#pragma unroll
        for (int b = 0; b < 2; ++b)
#pragma unroll
            for (int m = 0; m < 4; ++m)
#pragma unroll
                for (int n = 0; n < 2; ++n) acc[a][b][m][n] = (f32x4){0.f, 0.f, 0.f, 0.f};
    bf16x8 At[4][2], B0[2][2], B1[2][2];
    const char* cA = cur.A; const char* cB = cur.B;
    PG8_STAGE(PG8_SB(0, 0), cB, voffB); PG8_STAGE(PG8_SA(0, 0), cA, voffA); PG8_STAGE(PG8_SB(0, 1), cB + hstepB, voffB); PG8_STAGE(PG8_SA(0, 1), cA + hstepA, voffA);
    if (wr == 1) PG8_BAR;
    PG8_WAIT_V(4); PG8_BAR;
    PG8_STAGE(PG8_SB(1, 0), cB + kstep, voffB); PG8_STAGE(PG8_SA(1, 0), cA + kstep, voffA); PG8_STAGE(PG8_SB(1, 1), cB + hstepB + kstep, voffB);
    PG8_WAIT_V(6); PG8_BAR;
    for (;;) {
        const bool has_next = S.next(ui + 1, nxt);
        const char* nA = has_next ? nxt.A : cA; const char* nB = has_next ? nxt.B : cB;
        for (int t = 0; t < nt; t += 2) {
            const bool last = (t == nt - 2);
            const char* a1 = cA + (size_t)(t + 1) * kstep;
            const char* a2 = last ? nA : cA + (size_t)(t + 2) * kstep; const char* b2 = last ? nB : cB + (size_t)(t + 2) * kstep;
            const char* a3 = a2 + kstep; const char* b3 = b2 + kstep;
            PG8_LDB(B0, 0, 0); PG8_SCHED; PG8_LDA(At, 0, 0); PG8_STAGE(PG8_SA(1, 1), a1 + hstepA, voffA);
            PG8_WAIT_L(8); PG8_BAR; PG8_WAIT_L(0); PG8_MMA(0, 0, At, B0); PG8_BAR; PG8_SCHED;
            PG8_LDB(B1, 0, 1); PG8_STAGE(PG8_SB(0, 0), b2, voffB);
            PG8_BAR; PG8_WAIT_L(0); PG8_MMA(0, 1, At, B1); PG8_BAR;
            PG8_LDA(At, 0, 1); PG8_STAGE(PG8_SA(0, 0), a2, voffA);
            PG8_BAR; PG8_WAIT_L(0); PG8_MMA(1, 0, At, B0); PG8_BAR; PG8_SCHED;
            PG8_STAGE(PG8_SB(0, 1), b2 + hstepB, voffB);
            PG8_WAIT_V(6); PG8_BAR; PG8_MMA(1, 1, At, B1); PG8_BAR;
            PG8_LDB(B0, 1, 0); PG8_SCHED; PG8_LDA(At, 1, 0); PG8_STAGE(PG8_SA(0, 1), a2 + hstepA, voffA);
            PG8_WAIT_L(8); PG8_BAR; PG8_WAIT_L(0); PG8_MMA(0, 0, At, B0); PG8_BAR; PG8_SCHED;
            PG8_LDB(B1, 1, 1); PG8_STAGE(PG8_SB(1, 0), b3, voffB);
            PG8_BAR; PG8_WAIT_L(0); PG8_MMA(0, 1, At, B1); PG8_BAR;
            PG8_LDA(At, 1, 1); PG8_STAGE(PG8_SA(1, 0), a3, voffA);
            PG8_BAR; PG8_WAIT_L(0); PG8_MMA(1, 0, At, B0); PG8_BAR; PG8_SCHED;
            PG8_STAGE(PG8_SB(1, 1), b3 + hstepB, voffB);
            PG8_WAIT_V(6); PG8_BAR; PG8_MMA(1, 1, At, B1); PG8_BAR;
        }
        E(acc, cur, wr, wc, fr, fq);
        if (!has_next) break;
#pragma unroll
        for (int a = 0; a < 2; ++a)
#pragma unroll
            for (int b = 0; b < 2; ++b)
#pragma unroll
                for (int m = 0; m < 4; ++m)
#pragma unroll
                    for (int n = 0; n < 2; ++n) acc[a][b][m][n] = (f32x4){0.f, 0.f, 0.f, 0.f};
        cur = nxt; cA = nA; cB = nB; ++ui;
    }
    PG8_WAIT_V(0);
    if (wr == 0) PG8_BAR;
    PG8_BAR;
#undef PG8_SA
#undef PG8_SB
#undef PG8_STAGE
#undef PG8_LDA
#undef PG8_LDB
#undef PG8_MMA
#undef PG8_WAIT_V
#undef PG8_WAIT_L
#undef PG8_BAR
#undef PG8_SCHED
}
}
using pg8::Unit;
typedef f32x4 AccT[2][2][4][2];

struct RowSched {
    const char* A; const char* B; size_t astep, bstep; int nN, G, c;
    DEVI bool next(int i, Unit& u) const {
        const int x = c & 7, slot = c >> 3, nb = (G - x + 7) >> 3, per = 18 * nN, q = i * nb + slot;
        if (q >= per) return false;
        u.pm = x * 18 + q / nN; u.pn = q % nN; u.b = 0; u.x = 0;
        u.A = A + (size_t)u.pm * astep; u.B = B + (size_t)u.pn * bstep; return true;
    }
};
struct RowSchedLim {
    const char* A; const char* B; size_t astep, bstep; int nN, G, c, qlim;
    DEVI bool next(int i, Unit& u) const {
        const int x = c & 7, slot = c >> 3, nb = (G - x + 7) >> 3, q = i * nb + slot;
        if (q >= 18 * nN || q >= qlim) return false;
        u.pm = x * 18 + q / nN; u.pn = q % nN; u.b = 0; u.x = 0;
        u.A = A + (size_t)u.pm * astep; u.B = B + (size_t)u.pn * bstep; return true;
    }
};
struct RowSchedTail {
    const char* A; const char* B; size_t astep, bstep; int c;
    DEVI bool next(int i, Unit& u) const {
        const int x = c & 7, slot = c >> 3; if (i > 0 || slot >= 8) return false;
        const int q = 64 + slot; u.pm = x * 18 + (q >> 2); u.pn = q & 3; u.b = 0; u.x = 0;
        u.A = A + (size_t)u.pm * astep; u.B = B + (size_t)u.pn * bstep; return true;
    }
};
struct CombEarlySched {
    const char* A; const char* B; size_t astep, bstep; int c;
    DEVI bool next(int i, Unit& u) const {
        const int x = c & 7, slot = c >> 3; if (i > 0 || slot < 16) return false;
        const int t = slot - 16; u.pm = x * 18 + (t >> 2); u.pn = t & 3; u.b = 0; u.x = 0;
        u.A = A + (size_t)u.pm * astep; u.B = B + (size_t)u.pn * bstep; return true;
    }
};
struct CombLateSched {
    const char* A; const char* B; size_t astep, bstep; int c;
    DEVI bool next(int i, Unit& u) const {
        const int x = c & 7, slot = c >> 3, r = i * 32 + slot; if (r >= 128) return false;
        int pl, h; if (r < 16) { pl = r >> 2; h = 4 + (r & 3); } else { const int rp = r - 16; pl = 4 + (rp >> 3); h = rp & 7; }
        u.pm = x * 18 + pl; u.pn = h; u.b = 0; u.x = 0;
        u.A = A + (size_t)u.pm * astep; u.B = B + (size_t)u.pn * bstep; return true;
    }
};
struct DftSSched {
    const char* D; const char* HT; int G, c;
    DEVI bool next(int i, Unit& u) const {
        const int x = c & 7, slot = c >> 3, nb = (G - x + 7) >> 3, q = i * nb + slot;
        if (q >= 128) return false;
        u.b = x; u.pm = q >> 2; u.pn = q & 3; u.x = 0;
        u.A = D + (size_t)u.pm * 256 * 4096 * 2; u.B = HT + ((size_t)x * 1024 + (size_t)u.pn * 256) * 4096 * 2; return true;
    }
};
struct Dft2Sched {
    const char* DF; const char* Y; int G, c;
    DEVI bool next(int i, Unit& u) const {
        const int x = c & 7, slot = c >> 3, nb = (G - x + 7) >> 3, q = i * nb + slot;
        if (q >= 128) return false;
        u.b = x; u.x = q >> 3; u.pm = (q >> 2) & 1; u.pn = q & 3;
        u.A = DF + (size_t)u.pm * 256 * 512 * 2; u.B = Y + (((size_t)x * 16 + u.x) * 1024 + (size_t)u.pn * 256) * 512 * 2; return true;
    }
};
struct DftPSched {
    const char* D; const char* HT; int G, c;
    DEVI bool next(int i, Unit& u) const {
        const int q = i * G + c; if (q >= 128) return false;
        u.b = q >> 3; u.pm = (q >> 2) & 1; u.pn = q & 3; u.x = 0;
        u.A = D + (size_t)u.pm * 256 * 256 * 2; u.B = HT + ((size_t)u.b * 1024 + (size_t)u.pn * 256) * 256 * 2; return true;
    }
};
struct WpSched {
    const char* DC; const char* WU; int G, c;
    DEVI bool next(int i, Unit& u) const {
        const int q = i * G + ((c + 128) % G); if (q >= 64) return false;
        u.x = q >> 5; u.b = (q >> 2) & 7; u.pn = q & 3; u.pm = 0;
        u.A = DC + (size_t)u.x * 256 * 256 * 2; u.B = WU + ((size_t)u.pn * 256 * 2048 + (size_t)u.b * 256) * 2; return true;
    }
};

struct EpiSiluStore {
    bf16_t* G;
    DEVI void operator()(const AccT& acc, const Unit& u, int wr, int wc, int fr, int fq) const {
        asm volatile("" : "+v"(fr), "+v"(fq));
#pragma unroll
        for (int ai = 0; ai < 2; ++ai)
#pragma unroll
            for (int m = 0; m < 4; ++m) {
                bf16_t* rowp = G + (size_t)(u.pm * 256 + ai * 128 + wr * 64 + m * 16 + fr) * 2048 + u.pn * 256 + wc * 32 + 8 * fq;
#pragma unroll
                for (int bj = 0; bj < 2; ++bj) { const f32x4 v0 = acc[ai][bj][m][0], v1 = acc[ai][bj][m][1];
                    u32x4 w; w.x = cvt_pk_bf16(silu_f(v0[0]), silu_f(v0[1])); w.y = cvt_pk_bf16(silu_f(v0[2]), silu_f(v0[3]));
                    w.z = cvt_pk_bf16(silu_f(v1[0]), silu_f(v1[1])); w.w = cvt_pk_bf16(silu_f(v1[2]), silu_f(v1[3]));
                    *(u32x4*)(rowp + bj * 128) = w; } }
    }
};
struct EpiMulInplace {
    bf16_t* G;
    DEVI void operator()(const AccT& acc, const Unit& u, int wr, int wc, int fr, int fq) const {
        asm volatile("" : "+v"(fr), "+v"(fq));
        bf16_t* base = G + (size_t)(u.pm * 256 + wr * 64 + fr) * 2048 + u.pn * 256 + wc * 32 + 8 * fq;
        u32x4 g[2][4][2];
#pragma unroll
        for (int ai = 0; ai < 2; ++ai)
#pragma unroll
            for (int m = 0; m < 4; ++m)
#pragma unroll
                for (int bj = 0; bj < 2; ++bj) g[ai][m][bj] = *(const u32x4*)(base + (size_t)(ai * 128 + m * 16) * 2048 + bj * 128);
#pragma unroll
        for (int ai = 0; ai < 2; ++ai)
#pragma unroll
            for (int m = 0; m < 4; ++m)
#pragma unroll
                for (int bj = 0; bj < 2; ++bj) { const f32x4 v0 = acc[ai][bj][m][0], v1 = acc[ai][bj][m][1]; const u32x4 gg = g[ai][m][bj]; u32x4 w;
                    w.x = cvt_pk_bf16(v0[0] * bf_lo(gg.x), v0[1] * bf_hi(gg.x)); w.y = cvt_pk_bf16(v0[2] * bf_lo(gg.y), v0[3] * bf_hi(gg.y));
                    w.z = cvt_pk_bf16(v1[0] * bf_lo(gg.z), v1[1] * bf_hi(gg.z)); w.w = cvt_pk_bf16(v1[2] * bf_lo(gg.w), v1[3] * bf_hi(gg.w));
                    *(u32x4*)(base + (size_t)(ai * 128 + m * 16) * 2048 + bj * 128) = w; }
    }
};
struct EpiDft {
    bf16_t* HCS; int prompt;
    DEVI void operator()(const AccT& acc, const Unit& u, int wr, int wc, int fr, int fq) const {
        asm volatile("" : "+v"(fr), "+v"(fq));
        const int part = prompt ? u.pm : (u.pm >> 4);
        const int tok0 = prompt ? u.b * 256 : TP + u.b * 4096 + (u.pm & 15) * 256;
#pragma unroll
        for (int ai = 0; ai < 2; ++ai)
#pragma unroll
            for (int m = 0; m < 4; ++m) {
                bf16_t* rowp = HCS + (size_t)(tok0 + ai * 128 + wr * 64 + m * 16 + fr) * 2048 + part * 1024 + u.pn * 256 + wc * 32 + 8 * fq;
#pragma unroll
                for (int bj = 0; bj < 2; ++bj) { const f32x4 v0 = acc[ai][bj][m][0], v1 = acc[ai][bj][m][1];
                    u32x4 w; w.x = cvt_pk_bf16(v0[0], v0[1]); w.y = cvt_pk_bf16(v0[2], v0[3]); w.z = cvt_pk_bf16(v1[0], v1[1]); w.w = cvt_pk_bf16(v1[2], v1[3]);
                    *(u32x4*)(rowp + bj * 128) = w; } }
    }
};
struct EpiDft2 {
    bf16_t* HCS;
    DEVI void operator()(const AccT& acc, const Unit& u, int wr, int wc, int fr, int fq) const {
        asm volatile("" : "+v"(fr), "+v"(fq));
        const size_t tok0 = (size_t)TP + (size_t)u.b * 4096 + u.x;
#pragma unroll
        for (int ai = 0; ai < 2; ++ai)
#pragma unroll
            for (int m = 0; m < 4; ++m) {
                bf16_t* rowp = HCS + (tok0 + (size_t)16 * (ai * 128 + wr * 64 + m * 16 + fr)) * 2048 + u.pm * 1024 + u.pn * 256 + wc * 32 + 8 * fq;
#pragma unroll
                for (int bj = 0; bj < 2; ++bj) { const f32x4 v0 = acc[ai][bj][m][0], v1 = acc[ai][bj][m][1];
                    u32x4 w; w.x = cvt_pk_bf16(v0[0], v0[1]); w.y = cvt_pk_bf16(v0[2], v0[3]); w.z = cvt_pk_bf16(v1[0], v1[1]); w.w = cvt_pk_bf16(v1[2], v1[3]);
                    *(u32x4*)(rowp + bj * 128) = w; } }
    }
};
struct EpiWp {
    bf16_t* W;
    DEVI void operator()(const AccT& acc, const Unit& u, int wr, int wc, int fr, int fq) const {
        asm volatile("" : "+v"(fr), "+v"(fq));
#pragma unroll
        for (int ai = 0; ai < 2; ++ai)
#pragma unroll
            for (int m = 0; m < 4; ++m) {
                bf16_t* rowp = W + (size_t)(u.b * 256 + ai * 128 + wr * 64 + m * 16 + fr) * 2048 + u.x * 1024 + u.pn * 256 + wc * 32 + 4 * fq;
#pragma unroll
                for (int bj = 0; bj < 2; ++bj)
#pragma unroll
                    for (int n = 0; n < 2; ++n) { const f32x4 v = acc[ai][bj][m][n]; u32x2 w; w.x = cvt_pk_bf16(v[0], v[1]); w.y = cvt_pk_bf16(v[2], v[3]);
                        *(u32x2*)(rowp + bj * 128 + n * 16) = w; } }
    }
};
struct EpiOut {
    const float* xp; const float* xs; float* X; const float* mod;
    DEVI void operator()(const AccT& acc, const Unit& u, int wr, int wc, int fr, int fq) const {
        asm volatile("" : "+v"(fr), "+v"(fq));
        const int tok0 = u.pm * 256; const int b9 = u.pm < 16 ? 0 : 1 + ((u.pm - 16) >> 4);
        const float* src = u.pm < 16 ? xp + (size_t)tok0 * 1024 : xs + (size_t)(tok0 - TP) * 1024;
        float* dst = X + (size_t)tok0 * 1024;
        const int col0 = u.pn * 256 + wc * 32 + 4 * fq;
        const float* gt = mod + b9 * 3072 + 2048 + col0;
        f32x4 gv[2][2];
#pragma unroll
        for (int bj = 0; bj < 2; ++bj)
#pragma unroll
            for (int n = 0; n < 2; ++n) gv[bj][n] = *(const f32x4*)(gt + bj * 128 + n * 16);
#pragma unroll
        for (int ai = 0; ai < 2; ++ai) {
            f32x4 xo[4][2][2];
#pragma unroll
            for (int m = 0; m < 4; ++m)
#pragma unroll
                for (int bj = 0; bj < 2; ++bj)
#pragma unroll
                    for (int n = 0; n < 2; ++n) xo[m][bj][n] = *(const f32x4*)(src + (size_t)(ai * 128 + wr * 64 + m * 16 + fr) * 1024 + col0 + bj * 128 + n * 16);
#pragma unroll
            for (int m = 0; m < 4; ++m)
#pragma unroll
                for (int bj = 0; bj < 2; ++bj)
#pragma unroll
                    for (int n = 0; n < 2; ++n) *(f32x4*)(dst + (size_t)(ai * 128 + wr * 64 + m * 16 + fr) * 1024 + col0 + bj * 128 + n * 16) = xo[m][bj][n] + gv[bj][n] * acc[ai][bj][m][n];
        }
    }
};
struct EpiAttnIn {
    bf16_t* qh; bf16_t* kh; bf16_t* vh; float* nck; float* ncv; const float* cost; const float* sint; int hh, j;
    DEVI void operator()(const AccT& acc, const Unit& u, int wr, int wc, int fr, int fq) const {
        asm volatile("" : "+v"(fr), "+v"(fq));
        const int kind = u.pn >> 2, hl = u.pn & 3; const bool prompt = u.pm < 16;
        const int sb = prompt ? 0 : (u.pm - 16) >> 4, tib = prompt ? 0 : (u.pm - 16) & 15;
        if (kind < 2) {
            const int axis = wc >> 1, w1 = wc & 1;
            const int cbase = hl * 256 + 64 * axis + 16 * w1 + 4 * fq;
            const int cst = hl * 256 + 64 * axis + 16 * w1 + ((fq & 1) ? 32 + 4 * (fq - 1) : 4 * fq);
            f32x4 csT[4], snT[4];
#pragma unroll
            for (int k = 0; k < 4; ++k) { csT[k] = (f32x4){1.f, 1.f, 1.f, 1.f}; snT[k] = (f32x4){0.f, 0.f, 0.f, 0.f};
                if (!prompt && (axis || k < 2)) { const int pos = axis ? (16 * k + fr) : (4 * tib + 2 * k + wr); csT[k] = *(const f32x4*)(cost + pos * 32 + 16 * w1 + 4 * fq); snT[k] = *(const f32x4*)(sint + pos * 32 + 16 * w1 + 4 * fq); } }
#pragma unroll
            for (int ai = 0; ai < 2; ++ai)
#pragma unroll
                for (int m = 0; m < 4; ++m) {
                    const int r = ai * 128 + wr * 64 + m * 16 + fr;
                    const f32x4 cs = axis ? csT[m] : csT[ai], sn = axis ? snT[m] : snT[ai];
                    bf16_t* dst; float* fdst = nullptr;
                    if (kind == 0) dst = qh + (size_t)(u.pm * 256 + r) * 1024 + cst;
                    else if (prompt) { dst = kh + (size_t)(u.pm * 256 + r) * 1024 + cst; fdst = nck + ((size_t)(u.pm * 2 + j) * 256 + r) * 2048 + hh * 1024 + cbase; }
                    else dst = kh + (size_t)TP * 1024 + ((size_t)sb * 4608 + tib * 256 + r) * 1024 + cst;
#pragma unroll
                    for (int bj = 0; bj < 2; ++bj) { const f32x4 v0 = acc[ai][bj][m][0], v1 = acc[ai][bj][m][1];
                        const f32x4 o0 = v0 * cs - v1 * sn, o1 = v1 * cs + v0 * sn;
                        u32x2 a, b; a.x = cvt_pk_bf16(o0[0], o0[1]); a.y = cvt_pk_bf16(o0[2], o0[3]); b.x = cvt_pk_bf16(o1[0], o1[1]); b.y = cvt_pk_bf16(o1[2], o1[3]);
                        { auto r0 = __builtin_amdgcn_permlane16_swap(a.x, b.x, false, false); auto r1 = __builtin_amdgcn_permlane16_swap(a.y, b.y, false, false);
                          u32x4 w = {r0[0], r1[0], r0[1], r1[1]}; *(u32x4*)(dst + bj * 128) = w; }
                        if (fdst) { *(f32x4*)(fdst + bj * 128) = o0; *(f32x4*)(fdst + bj * 128 + 32) = o1; } } }
        } else {
            const int cbase = hl * 256 + wc * 32 + 8 * fq;
#pragma unroll
            for (int ai = 0; ai < 2; ++ai)
#pragma unroll
                for (int m = 0; m < 4; ++m) {
                    const int r = ai * 128 + wr * 64 + m * 16 + fr;
                    bf16_t* dst; float* fdst = nullptr;
                    if (prompt) { dst = vh + (size_t)(u.pm * 256 + r) * 1024 + cbase; fdst = ncv + ((size_t)(u.pm * 2 + j) * 256 + r) * 2048 + hh * 1024 + cbase; }
                    else dst = vh + (size_t)TP * 1024 + ((size_t)sb * 4608 + tib * 256 + r) * 1024 + cbase;
#pragma unroll
                    for (int bj = 0; bj < 2; ++bj) { const f32x4 v0 = acc[ai][bj][m][0], v1 = acc[ai][bj][m][1];
                        u32x4 w; w.x = cvt_pk_bf16(v0[0], v0[1]); w.y = cvt_pk_bf16(v0[2], v0[3]); w.z = cvt_pk_bf16(v1[0], v1[1]); w.w = cvt_pk_bf16(v1[2], v1[3]);
                        *(u32x4*)(dst + bj * 128) = w;
                        if (fdst) { *(f32x4*)(fdst + bj * 128) = v0; *(f32x4*)(fdst + bj * 128 + 4) = v1; } } }
        }
    }
};
struct EpiCombine {
    bf16_t* D; const float* ssq; const float* subln; float mul;
    DEVI void operator()(const AccT& acc, const Unit& u, int wr, int wc, int fr, int fq) const {
        asm volatile("" : "+v"(fr), "+v"(fq));
        const int h = u.pn; const int cb = wc * 32 + 8 * fq;
        f32x4 sg[2][2];
#pragma unroll
        for (int bj = 0; bj < 2; ++bj)
#pragma unroll
            for (int n = 0; n < 2; ++n) sg[bj][n] = *(const f32x4*)(subln + bj * 128 + cb + 4 * n);
        const size_t tokb = (size_t)(u.pm * 256 + wr * 64 + fr);
        bf16_t* base = D + tokb * 2048 + h * 256 + cb;
#pragma unroll
        for (int q = 0; q < 4; ++q) {
            const int ai = q >> 1, mb = (q & 1) * 2;
            u32x4 d[2][2]; float s0[2], s1[2];
#pragma unroll
            for (int mm = 0; mm < 2; ++mm) { const int m = mb + mm; const size_t tok = tokb + ai * 128 + m * 16; s0[mm] = ssq[tok * 16 + 2 * h]; s1[mm] = ssq[tok * 16 + 2 * h + 1];
#pragma unroll
                for (int bj = 0; bj < 2; ++bj) d[mm][bj] = *(const u32x4*)(base + (size_t)(ai * 128 + m * 16) * 2048 + bj * 128); }
#pragma unroll
            for (int mm = 0; mm < 2; ++mm) { const int m = mb + mm;
                const float rn = rsqrtf((s0[mm] + s1[mm]) * (1.f / 256.f) + 1e-6f) * mul;
#pragma unroll
                for (int bj = 0; bj < 2; ++bj) { const f32x4 v0 = acc[ai][bj][m][0], v1 = acc[ai][bj][m][1];
                    const u32x4 dd = d[mm][bj]; const f32x4 g0 = sg[bj][0] * rn, g1 = sg[bj][1] * rn; u32x4 w;
                    w.x = cvt_pk_bf16(bf_lo(dd.x) * g0[0] * silu_f(v0[0]), bf_hi(dd.x) * g0[1] * silu_f(v0[1]));
                    w.y = cvt_pk_bf16(bf_lo(dd.y) * g0[2] * silu_f(v0[2]), bf_hi(dd.y) * g0[3] * silu_f(v0[3]));
                    w.z = cvt_pk_bf16(bf_lo(dd.z) * g1[0] * silu_f(v1[0]), bf_hi(dd.z) * g1[1] * silu_f(v1[1]));
                    w.w = cvt_pk_bf16(bf_lo(dd.w) * g1[2] * silu_f(v1[2]), bf_hi(dd.w) * g1[3] * silu_f(v1[3]));
                    *(u32x4*)(base + (size_t)(ai * 128 + m * 16) * 2048 + bj * 128) = w; } }
        }
    }
};

namespace att {
constexpr int D = 128, KVBLK = 64, LD = 1024;
constexpr float SCALE = 0.088388347648318440f;
constexpr float THR = 8.f;
constexpr int OFF_V = 0, OFF_K = 65536, OFF_XP = 98304, OFF_XMAX = 114688, OFF_WS = 115712, OFF_XL = 117760, SHM_ATTN = 118784;
#define KSWZ(row, colB) ((row) * 256 + ((colB) ^ (((row) & 7) << 4)))
#define SBAR() __builtin_amdgcn_sched_barrier(0)
DEVI int crow(int r, int hi) { return (r & 3) + 8 * (r >> 2) + 4 * hi; }
DEVI void qkt_half(f32x16& p, const char* Ks, const bf16x8* qr, int krow, int hi) {
    bf16x8 kf[8];
#pragma unroll
    for (int d0 = 0; d0 < 8; ++d0) { const int cb = (d0 * 16 + hi * 8) * 2; kf[d0] = *reinterpret_cast<const bf16x8*>(Ks + KSWZ(krow, cb)); }
    SBAR();
    p = f32x16{};
#pragma unroll
    for (int d0 = 0; d0 < 8; ++d0) p = __builtin_amdgcn_mfma_f32_32x32x16_bf16(kf[d0], qr[d0], p, 0, 0, 0);
}
DEVI int v_st(int k, int c) { const int kk = (k & ~0xC) | ((k & 4) << 1) | ((k & 8) >> 1); return ((kk >> 3) * 4 + (c >> 5)) * 512 + ((kk & 7) * 32 + (c & 31)) * 2; }
DEVI int v_rd_base(int lane) { return ((lane & 3) << 3) | (((lane >> 2) & 3) << 6) | (((lane >> 4) & 1) << 5) | (((lane >> 5) & 1) << 8); }
constexpr int v_rd_off(int d0, int ks, int half) { return d0 * 512 + ks * 4096 + half * 2048; }
template <int OFF> DEVI s16x4 tr_read(int vb) {
    s16x4 r; asm volatile("ds_read_b64_tr_b16 %0, %1 offset:%2" : "=&v"(r) : "v"(vb), "i"(OFF) : "memory"); return r;
}
struct VFrag { s16x4 l0, h0, l1, h1, l2, h2, l3, h3; };
template <int D0> DEVI void pv_reads(VFrag& f, int vb) {
    f.l0 = tr_read<v_rd_off(D0, 0, 0)>(vb); f.h0 = tr_read<v_rd_off(D0, 0, 1)>(vb); f.l1 = tr_read<v_rd_off(D0, 1, 0)>(vb); f.h1 = tr_read<v_rd_off(D0, 1, 1)>(vb);
    f.l2 = tr_read<v_rd_off(D0, 2, 0)>(vb); f.h2 = tr_read<v_rd_off(D0, 2, 1)>(vb); f.l3 = tr_read<v_rd_off(D0, 3, 0)>(vb); f.h3 = tr_read<v_rd_off(D0, 3, 1)>(vb);
}
DEVI void pv_mma(f32x16& od, const VFrag& f, bf16x8 pa0, bf16x8 pa1, bf16x8 pa2, bf16x8 pa3) {
#define PK(L, H) (bf16x8){L[0], L[1], L[2], L[3], H[0], H[1], H[2], H[3]}
    od = __builtin_amdgcn_mfma_f32_32x32x16_bf16(pa0, PK(f.l0, f.h0), od, 0, 0, 0);
    od = __builtin_amdgcn_mfma_f32_32x32x16_bf16(pa1, PK(f.l1, f.h1), od, 0, 0, 0);
    od = __builtin_amdgcn_mfma_f32_32x32x16_bf16(pa2, PK(f.l2, f.h2), od, 0, 0, 0);
    od = __builtin_amdgcn_mfma_f32_32x32x16_bf16(pa3, PK(f.l3, f.h3), od, 0, 0, 0);
#undef PK
}
DEVI void pv_d0(f32x16* o, int vb, bf16x8 pa0, bf16x8 pa1, bf16x8 pa2, bf16x8 pa3) {
    VFrag fa, fb;
    pv_reads<0>(fa, vb); pv_reads<1>(fb, vb);
    asm volatile("s_waitcnt lgkmcnt(8)" ::: "memory"); SBAR();
    pv_mma(o[0], fa, pa0, pa1, pa2, pa3); SBAR();
    pv_reads<2>(fa, vb);
    asm volatile("s_waitcnt lgkmcnt(8)" ::: "memory"); SBAR();
    pv_mma(o[1], fb, pa0, pa1, pa2, pa3); SBAR();
    pv_reads<3>(fb, vb);
    asm volatile("s_waitcnt lgkmcnt(8)" ::: "memory"); SBAR();
    pv_mma(o[2], fa, pa0, pa1, pa2, pa3); SBAR();
    asm volatile("s_waitcnt lgkmcnt(0)" ::: "memory"); SBAR();
    pv_mma(o[3], fb, pa0, pa1, pa2, pa3);
}
DEVI float own_max(const f32x16& p) {
    float pm = p[0];
#pragma unroll
    for (int r = 1; r < 16; ++r) pm = fmaxf(pm, p[r]);
    auto rr = __builtin_amdgcn_permlane32_swap(__float_as_uint(pm), __float_as_uint(pm), false, false);
    return fmaxf(__uint_as_float(rr[0]), __uint_as_float(rr[1]));
}
DEVI void sm_finish(f32x16& p, float pmax, float& m_reg, float& l_reg, float& alpha, bf16x8& f0, bf16x8& f1) {
    constexpr float C = SCALE * 1.4426950408889634f;
    float mn;
    if (__builtin_expect(__all(pmax - m_reg <= THR / SCALE), 1)) { mn = m_reg; alpha = 1.f; }
    else { mn = fmaxf(m_reg, pmax); alpha = __builtin_amdgcn_exp2f((m_reg - mn) * C); m_reg = mn; }
    const float mnC = -mn * C;
#pragma unroll
    for (int r = 0; r < 16; ++r) p[r] = __builtin_amdgcn_exp2f(fmaf(p[r], C, mnC));
    float ps = 0;
#pragma unroll
    for (int r = 0; r < 16; ++r) ps += p[r];
    { auto rr = __builtin_amdgcn_permlane32_swap(__float_as_uint(ps), __float_as_uint(ps), false, false);
      ps = __uint_as_float(rr[0]) + __uint_as_float(rr[1]); }
    l_reg = l_reg * alpha + ps;
#define PK4(P, BASE, OUT) do { unsigned a0 = cvt_pk_bf16(P[BASE + 0], P[BASE + 1]), a1 = cvt_pk_bf16(P[BASE + 2], P[BASE + 3]);   \
    unsigned b0 = cvt_pk_bf16(P[BASE + 4], P[BASE + 5]), b1 = cvt_pk_bf16(P[BASE + 6], P[BASE + 7]);                              \
    auto r0 = __builtin_amdgcn_permlane32_swap(a0, b0, false, false); auto r1 = __builtin_amdgcn_permlane32_swap(a1, b1, false, false); \
    u32x4 w = {r0[0], r1[0], r0[1], r1[1]}; OUT = *reinterpret_cast<bf16x8*>(&w); } while (0)
    PK4(p, 0, f0); PK4(p, 8, f1);
#undef PK4
}

DEVI void attn_run(const bf16_t* __restrict__ Qb, const bf16_t* __restrict__ Kh, const bf16_t* __restrict__ Vh, int seq, char* lds, f32x16 (&o)[4], int wv) {
    const int tid = otid(wv), wid = tid >> 6, lane = tid & 63, r32 = lane & 31, hi = lane >> 5, g = wid >> 1, vh = wid & 1;
    char* V_lds = lds + OFF_V; char* K_lds = lds + OFF_K; char* xP = lds + OFF_XP;
    float* xmax = (float*)(lds + OFF_XMAX); float* xl = (float*)(lds + OFF_XL);
    float* al_l = (float*)(lds + OFF_WS) + wid * 64;
    float m_reg = -1e30f, l_reg = 0; bf16x8 qr[8];
#pragma unroll
    for (int d = 0; d < 4; ++d) o[d] = f32x16{};
    const bf16_t* Qw = Qb + (long)(g * 32 + r32) * LD + hi * 8;
#pragma unroll
    for (int d0 = 0; d0 < 8; ++d0) qr[d0] = *reinterpret_cast<const bf16x8*>(Qw + d0 * 16);
    const int sr = tid >> 4, sc = (tid & 15) * 8, vst0 = v_st(sr, sc), vst1 = v_st(32 + sr, sc);
    const int vb0 = (int)(uintptr_t)V_lds + vh * 16384 + v_rd_base(lane);
    const int krow = 32 * vh + r32;
    const int xp_own = (wid * 2) * 1024 + lane * 16, xp_oth = ((wid ^ 1) * 2) * 1024 + lane * 16;
    bf16x8 sva0, sva1, svc0, svc1, sks0, sks1;
#define SLOAD(k0) do { const bf16_t* vp_ = &Vh[(long)((k0) + sr) * LD + sc]; const bf16_t* kp_ = &Kh[(long)((k0) + sr) * LD + sc]; \
    sva0 = *reinterpret_cast<const bf16x8*>(vp_); sva1 = *reinterpret_cast<const bf16x8*>(vp_ + 32 * LD); \
    svc0 = *reinterpret_cast<const bf16x8*>(vp_ + 128); svc1 = *reinterpret_cast<const bf16x8*>(vp_ + 32 * LD + 128); \
    sks0 = *reinterpret_cast<const bf16x8*>(kp_); sks1 = *reinterpret_cast<const bf16x8*>(kp_ + 32 * LD); } while (0)
#define SWRITE(b) do { char* vd_ = V_lds + (b) * 32768; \
    *(bf16x8*)(vd_ + vst0) = sva0; *(bf16x8*)(vd_ + vst1) = sva1; *(bf16x8*)(vd_ + 16384 + vst0) = svc0; *(bf16x8*)(vd_ + 16384 + vst1) = svc1; \
    const int kc = sc * 2; *(bf16x8*)(K_lds + (b) * 16384 + KSWZ(sr, kc)) = sks0; *(bf16x8*)(K_lds + (b) * 16384 + KSWZ(32 + sr, kc)) = sks1; } while (0)
#define RESC(a) do { if (__any((a) < 1.f)) { if (hi == 0) al_l[r32] = (a); asm volatile("s_waitcnt lgkmcnt(0)" ::: "memory"); \
    _Pragma("unroll") for (int d = 0; d < 4; ++d) _Pragma("unroll") for (int r = 0; r < 16; ++r) o[d][r] *= al_l[crow(r, hi)]; } } while (0)
#define ATT_STEP(BUF, WRITEC, LOADC, LOADK) do { \
    SBAR(); qkt_half(p, K_lds + (BUF) * 16384, qr, krow, hi); \
    pf0 = *(const bf16x8*)(xP + xp_oth); pf1 = *(const bf16x8*)(xP + xp_oth + 1024); SBAR(); \
    pv_d0(o, vb0 + (1 - (BUF)) * 32768, vh ? pf0 : f0, vh ? pf1 : f1, vh ? f0 : pf0, vh ? f1 : pf1); SBAR(); \
    pm = own_max(p); if (hi == 0) xmax[wid * 32 + r32] = pm; \
    __syncthreads(); \
    if (WRITEC) { SWRITE(1 - (BUF)); if (LOADC) SLOAD(LOADK); } \
    { const float pmax = fmaxf(pm, xmax[(wid ^ 1) * 32 + r32]); sm_finish(p, pmax, m_reg, l_reg, alpha, f0, f1); } \
    *(bf16x8*)(xP + xp_own) = f0; *(bf16x8*)(xP + xp_own + 1024) = f1; \
    RESC(alpha); __syncthreads(); } while (0)
    f32x16 p; float pm, alpha; bf16x8 f0, f1, pf0, pf1; const int NT = seq / KVBLK;
    SLOAD(0); asm volatile("s_waitcnt vmcnt(0)" ::: "memory"); SWRITE(0); SLOAD(KVBLK); __syncthreads();
    qkt_half(p, K_lds, qr, krow, hi);
    pm = own_max(p); if (hi == 0) xmax[wid * 32 + r32] = pm;
    __syncthreads();
    SWRITE(1); if (2 < NT) SLOAD(2 * KVBLK);
    { const float pmax = fmaxf(pm, xmax[(wid ^ 1) * 32 + r32]); sm_finish(p, pmax, m_reg, l_reg, alpha, f0, f1); }
    *(bf16x8*)(xP + xp_own) = f0; *(bf16x8*)(xP + xp_own + 1024) = f1;
    __syncthreads();
    for (int j = 1; j + 1 < NT; j += 2) {
        ATT_STEP(1, true, true, (j + 2) * KVBLK);
        ATT_STEP(0, true, (j + 3 < NT), (j + 3) * KVBLK);
    }
    ATT_STEP(1, false, false, 0);
    pf0 = *(const bf16x8*)(xP + xp_oth); pf1 = *(const bf16x8*)(xP + xp_oth + 1024);
    pv_d0(o, vb0 + 32768, vh ? pf0 : f0, vh ? pf1 : f1, vh ? f0 : pf0, vh ? f1 : pf1);
    if (hi == 0) xl[wid * 32 + r32] = l_reg;
    __syncthreads();
#pragma unroll
    for (int r = 0; r < 16; ++r) { const int rw = crow(r, hi); const float rl = __builtin_amdgcn_rcpf(xl[wid * 32 + rw] + xl[(wid ^ 1) * 32 + rw]);
#pragma unroll
        for (int d = 0; d < 4; ++d) o[d][r] *= rl; }
    __syncthreads();
#undef SLOAD
#undef SWRITE
#undef SWAIT
#undef RESC
#undef ATT_STEP
}

DEVI void attn_item(const bf16_t* Q0, const bf16_t* K0, const bf16_t* V, int seq, float lam, bf16_t* diffp, float* ssqp, char* lds, unsigned* stash, int wv) {
    asm volatile("" : "+s"(seq));
    {
        f32x16 o[4];
        attn_run(Q0, K0, V, seq, lds, o, wv);
        const int tid = otid(wv);
#pragma unroll
        for (int d = 0; d < 4; ++d)
#pragma unroll
            for (int r = 0; r < 8; ++r) stash[(d * 8 + r) * 512 + tid] = cvt_pk_bf16(o[d][2 * r], o[d][2 * r + 1]);
    }
    asm volatile("" : "+s"(seq));
    {
        f32x16 o[4];
        attn_run(Q0 + 128, K0 + 128, V, seq, lds, o, wv);
        const int tid = otid(wv);
        const int wid = tid >> 6, lane = tid & 63, r32 = lane & 31, hi = lane >> 5, g = wid >> 1, vh = wid & 1;
        float ss[16];
#pragma unroll
        for (int r = 0; r < 16; ++r) ss[r] = 0.f;
#pragma unroll
        for (int d = 0; d < 4; ++d)
#pragma unroll
            for (int r = 0; r < 8; ++r) { const unsigned w = stash[(d * 8 + r) * 512 + tid];
                o[d][2 * r] = bf_lo(w) - lam * o[d][2 * r]; o[d][2 * r + 1] = bf_hi(w) - lam * o[d][2 * r + 1];
                ss[2 * r] += o[d][2 * r] * o[d][2 * r]; ss[2 * r + 1] += o[d][2 * r + 1] * o[d][2 * r + 1]; }
#pragma unroll
        for (int r = 0; r < 16; ++r) { float v = ss[r]; v += shx(v, 16, lane); v += shx(v, 8, lane); v += shx(v, 4, lane); v += shx(v, 2, lane); v += shx(v, 1, lane); ss[r] = v; }
        if (r32 == 0) {
#pragma unroll
            for (int r = 0; r < 16; ++r) ssqp[(size_t)(g * 32 + crow(r, hi)) * 16 + vh] = ss[r];
        }
        const bool oddl = (lane & 1) != 0;
#pragma unroll
        for (int r2 = 0; r2 < 8; ++r2) { bf16_t* rp = diffp + (size_t)(g * 32 + crow(2 * r2 + (oddl ? 1 : 0), hi)) * 2048 + vh * 128 + (r32 & ~1);
#pragma unroll
            for (int d = 0; d < 4; ++d) { const float snd = oddl ? o[d][2 * r2] : o[d][2 * r2 + 1];
                const float rcv = __int_as_float(__builtin_amdgcn_mov_dpp(__float_as_int(snd), 0xB1, 0xF, 0xF, true));
                *(unsigned*)(rp + d * 32) = oddl ? cvt_pk_bf16(rcv, o[d][2 * r2 + 1]) : cvt_pk_bf16(o[d][2 * r2], rcv); } }
    }
}
}

DEVI void phase_mod(const Params& p, float* sl, int c, int tid) {
    if (c >= 192) return;
    float* scond = sl; float* red = sl + 9 * 1024;
    for (int idx = tid; idx < 9 * 1024; idx += NTHREADS) { const int b = idx >> 10, k = idx & 1023; const float v = b == 0 ? p.c_ctx[k] : p.c[(b - 1) * 1024 + k]; scond[idx] = silu_f(v); }
    __syncthreads();
    const int i = c / 48, n0 = (c % 48) * 64, col = tid & 63, kg = tid >> 6;
    const float* w = p.w_ada + (size_t)i * 1024 * 3072 + n0 + col;
    float acc[9];
#pragma unroll
    for (int b = 0; b < 9; ++b) acc[b] = 0.f;
#pragma unroll 8
    for (int k = kg; k < 1024; k += 8) { const float wv = w[(size_t)k * 3072];
#pragma unroll
        for (int b = 0; b < 9; ++b) acc[b] += scond[b * 1024 + k] * wv; }
#pragma unroll
    for (int b = 0; b < 9; ++b) red[(kg * 9 + b) * 64 + col] = acc[b];
    __syncthreads();
    float* mod = (float*)(p.ws + WS_MOD);
    for (int idx = tid; idx < 576; idx += NTHREADS) { const int b = idx >> 6, cc = idx & 63; float s = 0.f;
#pragma unroll
        for (int g = 0; g < 8; ++g) s += red[(g * 9 + b) * 64 + cc];
        mod[(size_t)(i * 9 + b) * 3072 + n0 + cc] = s + p.b_ada[i * 3072 + n0 + cc]; }
    __syncthreads();
}
DEVI void phase_small(const Params& p, int c, int G, int tid) {
    if (c == 192 % G && tid < 64) {
        for (int j = 0; j < 2; ++j) {
            float a = p.lam_q1[j * 128 + tid] * p.lam_k1[j * 128 + tid] + p.lam_q1[j * 128 + 64 + tid] * p.lam_k1[j * 128 + 64 + tid];
            float b = p.lam_q2[j * 128 + tid] * p.lam_k2[j * 128 + tid] + p.lam_q2[j * 128 + 64 + tid] * p.lam_k2[j * 128 + 64 + tid];
            a = wave_sum(a, tid); b = wave_sum(b, tid);
            const float lam_init = 0.8f - 0.6f * expf(-0.3f * (float)(2 * j + 1));
            if (tid == 0) ((float*)(p.ws + WS_LAM))[j] = expf(a) - expf(b) + lam_init;
        }
    }
    if (c == 193 % G) {
        for (int e = tid; e < 2048; e += NTHREADS) { const int pos = e >> 5, idx = e & 31;
            const float inv = exp2f(-(float)idx * (13.287712379549449f / 32.f));
            const float rev = (float)pos * inv * 0.15915494309189535f;
            ((float*)(p.ws + WS_COS))[e] = __builtin_amdgcn_cosf(rev); ((float*)(p.ws + WS_SIN))[e] = __builtin_amdgcn_sinf(rev); }
    }
    for (int e = c * NTHREADS + tid; e < 512 * 256 + 2 * 256 * 256; e += G * NTHREADS) {
        if (e < 512 * 256) { const int r = e >> 8, m = e & 255, ph = ((r & 255) * m) & 255; const float rev = (float)ph * (1.f / 256.f);
            const float v = (r < 256 ? __builtin_amdgcn_cosf(rev) : __builtin_amdgcn_sinf(rev)) * (1.f / 16.f);
            ((bf16_t*)(p.ws + WS_D256))[e] = (bf16_t)(cvt_pk_bf16(v, 0.f) & 0xffffu);
        } else { const int e2 = e - 512 * 256, part = e2 >> 16, s = (e2 >> 8) & 255, cc = e2 & 255; const int n = (s & ~31) | perm32(s & 31);
            const int ph = (n * cc) & 255; const float rev = (float)ph * (1.f / 256.f);
            const float v = (part == 0 ? __builtin_amdgcn_cosf(rev) : -__builtin_amdgcn_sinf(rev)) * (1.f / 16.f);
            ((bf16_t*)(p.ws + WS_DC256))[e2] = (bf16_t)(cvt_pk_bf16(v, 0.f) & 0xffffu); }
    }
}
DEVI void gen_df512(const Params& p, int c, int G, int tid) {
    bf16_t* DF = (bf16_t*)(p.ws + WS_DF512);
    for (int e = c * NTHREADS + tid; e < 512 * 512; e += G * NTHREADS) {
        const int r = e >> 9, kk = e & 511, ph = ((r & 255) * (kk & 255)) & 255; const float rev = (float)ph * (1.f / 256.f);
        const float cs = __builtin_amdgcn_cosf(rev), sn = __builtin_amdgcn_sinf(rev);
        const float v = (r < 256 ? (kk < 256 ? cs : sn) : (kk < 256 ? sn : -cs)) * (1.f / 64.f);
        DF[e] = (bf16_t)(cvt_pk_bf16(v, 0.f) & 0xffffu);
    }
}
constexpr float kC16[16] = {1.f, 0.92387953251f, 0.70710678119f, 0.38268343237f, 0.f, -0.38268343237f, -0.70710678119f, -0.92387953251f,
                            -1.f, -0.92387953251f, -0.70710678119f, -0.38268343237f, 0.f, 0.38268343237f, 0.70710678119f, 0.92387953251f};
DEVI void fft_prepass(const Params& p, unsigned char* ldsg, int c, int G, int tid) {
    const bf16_t* H = (const bf16_t*)(p.ws + F_H); bf16_t* Y = (bf16_t*)(p.ws + F_Y);
    const int p2 = tid & 31, cg = tid >> 5;
    for (int tile = c; tile < 1024; tile += G) {
        const int b = tile >> 7, n2_0 = ((tile >> 5) & 3) * 64, ch0 = (tile & 31) * 32;
#pragma unroll
        for (int it = 0; it < 8; ++it) { const int q = tid + NTHREADS * it, row = q >> 2, part = q & 3, n1 = row >> 6, n2l = row & 63;
            const bf16_t* src = H + ((size_t)TP + (size_t)b * 4096 + 256 * n1 + n2_0 + n2l) * 1024 + ch0 + part * 8;
            const u32x4 v = *(const u32x4*)src; u32x2* d = (u32x2*)(ldsg + row * 72 + part * 16); d[0] = (u32x2){v.x, v.y}; d[1] = (u32x2){v.z, v.w}; }
        __syncthreads();
#pragma unroll 1
        for (int chsel = 0; chsel < 2; ++chsel) {
            const int chl = 2 * cg + chsel;
            float yr[2][16], yi[2][16];
#pragma unroll
            for (int e = 0; e < 2; ++e) {
                const int n2l = 2 * p2 + e; float x[16];
#pragma unroll
                for (int n1 = 0; n1 < 16; ++n1) x[n1] = __uint_as_float((unsigned)(*(const bf16_t*)(ldsg + (n1 * 64 + n2l) * 72 + chl * 2)) << 16);
                float sm[8], df[8];
#pragma unroll
                for (int n = 1; n < 8; ++n) { sm[n] = x[n] + x[16 - n]; df[n] = x[n] - x[16 - n]; }
                float Ar[9], Ai[9];
#pragma unroll
                for (int k = 0; k <= 8; ++k) { float ar = x[0] + ((k & 1) ? -x[8] : x[8]), ai = 0.f;
#pragma unroll
                    for (int n = 1; n < 8; ++n) { ar += sm[n] * kC16[(n * k) & 15]; ai += df[n] * kC16[(n * k + 12) & 15]; }
                    Ar[k] = ar; Ai[k] = ai; }
                const int n2 = n2_0 + n2l;
#pragma unroll
                for (int k1 = 0; k1 < 16; ++k1) { const float ar = Ar[k1 <= 8 ? k1 : 16 - k1], ai = k1 <= 8 ? Ai[k1] : -Ai[16 - k1];
                    const float rev = (float)(n2 * k1) * (1.f / 4096.f); const float cs = __builtin_amdgcn_cosf(rev), sn = __builtin_amdgcn_sinf(rev);
                    yr[e][k1] = ar * cs - ai * sn; yi[e][k1] = -(ar * sn + ai * cs); }
            }
            const int ch = ch0 + chl, slot = (ch & ~31) | (16 * ((ch >> 2) & 1) + 4 * ((ch & 31) >> 3) + (ch & 3));
            bf16_t* yb = Y + (((size_t)b * 16) * 1024 + slot) * 512 + n2_0 + 2 * p2;
#pragma unroll
            for (int k1 = 0; k1 < 16; ++k1) { *(unsigned*)(yb + (size_t)k1 * 1024 * 512) = cvt_pk_bf16(yr[0][k1], yr[1][k1]); *(unsigned*)(yb + (size_t)k1 * 1024 * 512 + 256) = cvt_pk_bf16(yi[0][k1], yi[1][k1]); }
        }
        __syncthreads();
    }
}
DEVI int sigma64(int kind, int s) { return kind == 0 ? s : (kind == 1 ? ((s & 32) | perm32(s & 31)) : (32 * ((s >> 4) & 1) + 16 * (s >> 5) + (s & 15))); }
DEVI void cvt_tile(const float* src, int lds_, int k0, int c0, bf16_t* dst, int ldd, int r0, int kind, bf16_t* tl, int lane) {
    const int cl = (lane & 15) * 4, kr = lane >> 4;
#pragma unroll
    for (int it = 0; it < 16; ++it) { const int k = kr + 4 * it; const f32x4 v = *(const f32x4*)(src + (size_t)(k0 + k) * lds_ + c0 + cl);
        u32x2 w; w.x = cvt_pk_bf16(v[0], v[1]); w.y = cvt_pk_bf16(v[2], v[3]); *(u32x2*)(tl + k * 68 + cl) = w; }
    __builtin_amdgcn_fence(__ATOMIC_RELEASE, "wavefront"); __builtin_amdgcn_wave_barrier(); __builtin_amdgcn_fence(__ATOMIC_ACQUIRE, "wavefront");
    const int q = lane & 7, sr = lane >> 3;
#pragma unroll
    for (int it = 0; it < 8; ++it) { const int s = sr + 8 * it, col = sigma64(kind, s); unsigned e[8];
#pragma unroll
        for (int k = 0; k < 8; ++k) e[k] = tl[(8 * q + k) * 68 + col];
        u32x4 w; w.x = e[0] | (e[1] << 16); w.y = e[2] | (e[3] << 16); w.z = e[4] | (e[5] << 16); w.w = e[6] | (e[7] << 16);
        *(u32x4*)(dst + (size_t)(r0 + s) * ldd + k0 + 8 * q) = w; }
    __builtin_amdgcn_fence(__ATOMIC_RELEASE, "wavefront"); __builtin_amdgcn_wave_barrier(); __builtin_amdgcn_fence(__ATOMIC_ACQUIRE, "wavefront");
}
DEVI void cvt_weights_fourier(const Params& p, int l, unsigned char* ldsg, int c, int G, int tid, size_t wout_off) {
    const int lane = tid & 63, wid = tid >> 6, gw = c * 8 + wid, nw = G * 8;
    bf16_t* tl = (bf16_t*)(ldsg + wid * 8704);
    const float* win = p.w_in_f + (size_t)l * 1024 * 4096; const float* wout = p.w_out_f + (size_t)l * 2048 * 1024;
    for (int t = gw; t < 512 + 512; t += nw) {
        if (t < 512) { const int rb = t >> 4, kb = t & 15;
            cvt_tile(win, 4096, kb * 64, 2048 + rb * 64, (bf16_t*)(p.ws + WS_WG), 1024, rb * 64, 1, tl, lane);
        } else { const int t2 = t - 512, rb = t2 >> 5, kb = t2 & 31;
            cvt_tile(wout, 1024, kb * 64, rb * 64, (bf16_t*)(p.ws + wout_off), 2048, rb * 64, 0, tl, lane); }
    }
    bf16_t* wub = (bf16_t*)(p.ws + WS_WUB);
    for (int e = c * NTHREADS + tid; e < 1024 * 256; e += G * NTHREADS) { const int k = e >> 8, c8 = (e & 255) * 8;
        const f32x4 a = *(const f32x4*)(win + (size_t)k * 4096 + c8), b = *(const f32x4*)(win + (size_t)k * 4096 + c8 + 4);
        u32x4 w; w.x = cvt_pk_bf16(a[0], a[1]); w.y = cvt_pk_bf16(a[2], a[3]); w.z = cvt_pk_bf16(b[0], b[1]); w.w = cvt_pk_bf16(b[2], b[3]);
        *(u32x4*)(wub + (size_t)k * 2048 + c8) = w; }
}
DEVI void cvt_weights_attn(const Params& p, int j, unsigned char* ldsg, int c, int G, int tid, size_t wout_off) {
    const int lane = tid & 63, wid = tid >> 6, gw = c * 8 + wid, nw = G * 8;
    bf16_t* tl = (bf16_t*)(ldsg + wid * 8704);
    const float* win = p.w_in_a + (size_t)j * 1024 * 8192; const float* wout = p.w_out_a + (size_t)j * 2048 * 1024;
    for (int t = gw; t < 2048 + 512; t += nw) {
        if (t < 2048) { const int rb = t >> 4, kb = t & 15;
            const int tix = rb >> 2, qb = rb & 3; int scol, kind;
            if (tix < 24) { const int hh = tix / 12, kd = (tix % 12) >> 2, hl = tix & 3; scol = kd * 2048 + (hh * 4 + hl) * 256 + 64 * qb; kind = kd < 2 ? 2 : 1; }
            else { scol = 6144 + (tix - 24) * 256 + 64 * qb; kind = 1; }
            cvt_tile(win, 8192, kb * 64, scol, (bf16_t*)(p.ws + WS_WATT), 1024, rb * 64, kind, tl, lane);
        } else { const int t2 = t - 2048, rb = t2 >> 5, kb = t2 & 31;
            cvt_tile(wout, 1024, kb * 64, rb * 64, (bf16_t*)(p.ws + wout_off), 2048, rb * 64, 0, tl, lane); }
    }
}
DEVI int norm_ntiles(int c, int part) { asm volatile("" : "+s"(c)); const int slot = c >> 3; if (slot < 8) return part == 1 ? 0 : 1; if (part == 2) return 0; const int idx = (slot - 8) * 8 + (c & 7); return (512 - idx + 191) / 192; }
DEVI int norm_tile(int c, int i) {
    asm volatile("" : "+s"(c));
    const int slot = c >> 3, x = c & 7;
    if (slot < 8) return ((x * 18 + 16 + (slot & 1)) * 4 + (slot >> 1));
    const int k = (slot - 8) * 8 + x + 192 * i; return (((k & 7) * 18 + ((k >> 3) & 15)) * 4 + (k >> 7));
}
template <bool TRANS>
DEVI void norm_phase(const Params& p, int layer, const float* xp, const float* xs, bf16_t* H, bf16_t* HTp, bf16_t* HTs, unsigned char* ldsg, int c, int G, int tid, int part) {
    const int lane = tid & 63, wid = tid >> 6;
    const float* mod = (const float*)(p.ws + WS_MOD) + (size_t)layer * 9 * 3072;
    const float* g = p.norm_g + layer * 1024;
    const int nti = norm_ntiles(c, part);
    for (int ti = 0; ti < nti; ++ti) {
        const int tile = norm_tile(c, ti);
        const int t0 = tile * 64; const int b9 = t0 < TP ? 0 : 1 + ((t0 - TP) >> 12);
        const float* sh = mod + b9 * 3072; const float* sc = sh + 1024;
        f32x4 gm[4], sv[4];
#pragma unroll
        for (int it = 0; it < 4; ++it) { const int col = 4 * lane + 256 * it; const f32x4 gv = *(const f32x4*)(g + col), scv = *(const f32x4*)(sc + col);
            gm[it] = gv * (scv + 1.f); sv[it] = *(const f32x4*)(sh + col); }
        for (int rr = 0; rr < 8; ++rr) {
            const int row = wid * 8 + rr, t = t0 + row;
            const float* xr = t < TP ? xp + (size_t)t * 1024 : xs + (size_t)(t - TP) * 1024;
            f32x4 v[4]; float ss = 0.f;
#pragma unroll
            for (int it = 0; it < 4; ++it) { v[it] = *(const f32x4*)(xr + 4 * lane + 256 * it); ss += v[it][0] * v[it][0] + v[it][1] * v[it][1] + v[it][2] * v[it][2] + v[it][3] * v[it][3]; }
            ss = wave_sum(ss, lane);
            const float rs = rsqrtf(ss * (1.f / 1024.f) + 1e-6f);
#pragma unroll
            for (int it = 0; it < 4; ++it) { const int col = 4 * lane + 256 * it; const f32x4 h = v[it] * rs * gm[it] + sv[it];
                u32x2 w; w.x = cvt_pk_bf16(h[0], h[1]); w.y = cvt_pk_bf16(h[2], h[3]);
                *(u32x2*)(H + (size_t)t * 1024 + col) = w;
                if (TRANS && t0 < TP) *(u32x2*)(ldsg + ((size_t)row * 1028 + col) * 2) = w; }
        }
        if (TRANS && t0 < TP) {
            __syncthreads();
            const int chunk = tid & 7; bf16_t* dstb = HTp + (size_t)(t0 >> 8) * 1024 * 256 + (t0 & 255); const int ldt = 256;
#pragma unroll 4
            for (int it = 0; it < 16; ++it) { const int srow = (tid >> 3) + 64 * it; const int ch = (srow & ~31) | perm32(srow & 31); unsigned e[8];
#pragma unroll
                for (int k = 0; k < 8; ++k) e[k] = *(const bf16_t*)(ldsg + ((size_t)(8 * chunk + k) * 1028 + ch) * 2);
                u32x4 w; w.x = e[0] | (e[1] << 16); w.y = e[2] | (e[3] << 16); w.z = e[4] | (e[5] << 16); w.w = e[6] | (e[7] << 16);
                *(u32x4*)(dstb + (size_t)srow * ldt + 8 * chunk) = w; }
            __syncthreads();
        }
    }
}
DEVI void final_norm(const Params& p, int c, int G, int tid, int part) {
    const int lane = tid & 63, wid = tid >> 6;
    f32x4 gm[4];
#pragma unroll
    for (int it = 0; it < 4; ++it) gm[it] = *(const f32x4*)(p.final_g + 4 * lane + 256 * it);
    const int nti = norm_ntiles(c, part);
    for (int ti = 0; ti < nti; ++ti) {
        const int tile = norm_tile(c, ti);
        for (int rr = 0; rr < 8; ++rr) {
            const int t = tile * 64 + wid * 8 + rr;
            float* xr = p.out + (size_t)t * 1024; f32x4 v[4]; float ss = 0.f;
#pragma unroll
            for (int it = 0; it < 4; ++it) { v[it] = *(const f32x4*)(xr + 4 * lane + 256 * it); ss += v[it][0] * v[it][0] + v[it][1] * v[it][1] + v[it][2] * v[it][2] + v[it][3] * v[it][3]; }
            ss = wave_sum(ss, lane);
            const float rs = rsqrtf(ss * (1.f / 1024.f) + 1e-6f);
#pragma unroll
            for (int it = 0; it < 4; ++it) *(f32x4*)(xr + 4 * lane + 256 * it) = v[it] * rs * gm[it];
        }
    }
}
DEVI void cvt_cache(const Params& p, int j, int hh, int c, int G, int tid) {
    bf16_t* ks = (bf16_t*)(p.ws + A_K) + (size_t)TP * 1024; bf16_t* vs = (bf16_t*)(p.ws + A_V) + (size_t)TP * 1024;
    for (int e = c * NTHREADS + tid; e < 2 * 8 * 512 * 128; e += G * NTHREADS) {
        const int which = e >> 19, rem = e & ((1 << 19) - 1), b = rem >> 16, pp = (rem >> 7) & 511, ch = (rem & 127) * 8;
        const float* src = (which ? p.cache_v : p.cache_k) + ((size_t)(b * 2 + j) * 512 + pp) * 2048 + hh * 1024 + ch;
        bf16_t* dst = (which ? vs : ks) + ((size_t)b * 4608 + 4096 + pp) * 1024 + ch;
        const f32x4 a = *(const f32x4*)src, bb = *(const f32x4*)(src + 4);
        u32x4 w; w.x = cvt_pk_bf16(a[0], a[1]); w.y = cvt_pk_bf16(a[2], a[3]); w.z = cvt_pk_bf16(bb[0], bb[1]); w.w = cvt_pk_bf16(bb[2], bb[3]);
        *(u32x4*)dst = w;
    }
}
DEVI void attn_phase(const Params& p, int j, int hh, unsigned char* ldsg, int c, int G, int wv) {
    const bf16_t* qh = (const bf16_t*)(p.ws + A_Q); const bf16_t* kh = (const bf16_t*)(p.ws + A_K); const bf16_t* vh = (const bf16_t*)(p.ws + A_V);
    bf16_t* diff = (bf16_t*)(p.ws + A_DIFF); float* ssq = (float*)(p.ws + A_SSQ);
    unsigned* stash = (unsigned*)(p.ws + A_STASH) + (size_t)c * 16384;
    const float lam = ((const float*)(p.ws + WS_LAM))[j];
    const int x = c & 7, slot = c >> 3, nb = (G - x + 7) >> 3;
    const int ns = slot < 128 ? (128 - slot + nb - 1) / nb : 0;
    const int np = c < 128 ? (128 - c + G - 1) / G : 0;
#pragma nounroll
    for (int it = 0; it < ns + np; ++it) {
        const bf16_t *Q0, *K0, *V0; bf16_t* dp; float* sp; int seq;
        if (it < ns) {
            const int q = slot + it * nb, b = x, hl = q >> 5, qb = q & 31, h = hh * 4 + hl;
            const size_t tok0 = (size_t)TP + (size_t)b * 4096 + (size_t)qb * 128;
            Q0 = qh + tok0 * 1024 + hl * 256; K0 = kh + ((size_t)TP + (size_t)b * 4608) * 1024 + hl * 256; V0 = vh + ((size_t)TP + (size_t)b * 4608) * 1024 + hl * 256;
            dp = diff + tok0 * 2048 + h * 256; sp = ssq + tok0 * 16 + 2 * h; seq = 4608;
        } else {
            const int q = c + (it - ns) * G, b = q >> 3, hl = (q >> 1) & 3, qb = q & 1, h = hh * 4 + hl;
            const size_t tok0 = (size_t)b * 256 + (size_t)qb * 128;
            Q0 = qh + tok0 * 1024 + hl * 256; K0 = kh + (size_t)b * 256 * 1024 + hl * 256; V0 = vh + (size_t)b * 256 * 1024 + hl * 256;
            dp = diff + tok0 * 2048 + h * 256; sp = ssq + tok0 * 16 + 2 * h; seq = 256;
        }
        att::attn_item(Q0, K0, V0, seq, lam, dp, sp, (char*)ldsg, stash, wv);
    }
}

#define XB_TMO      128
#define XB_XCNT(j)  (256  + 64 * (j))
#define XB_XSUB(j)  (1280 + 64 * (j))
#define XB_XGEN(j)  (2304 + 64 * (j))
#define XB_TOP      3328
#define XB_TOPGEN   3392
#define XCD_BAR_WORDS 3456
#define XB_SPIN_CAP (1u << 18)
DEVI unsigned xb_ld(unsigned* p)              { return __hip_atomic_load(p, __ATOMIC_RELAXED, __HIP_MEMORY_SCOPE_AGENT); }
DEVI unsigned xb_add(unsigned* p, unsigned v) { return __hip_atomic_fetch_add(p, v, __ATOMIC_RELAXED, __HIP_MEMORY_SCOPE_AGENT); }
DEVI unsigned xb_xcc_id() { return (unsigned)__builtin_amdgcn_s_getreg((3 << 11) | 20) & 0xFu; }
#define XB_SPIN(cond, bar) do { unsigned _sp = 0; while (cond) { \
    if ((++_sp & 255u) == 0u) { if (xb_ld(&(bar)[XB_TMO])) break; if (_sp > XB_SPIN_CAP) { atomicAdd(&(bar)[XB_TMO], 1u); break; } } } } while (0)
DEVI void xcd_barrier_complete(unsigned* bar, unsigned x, unsigned& nloc, unsigned& nx) {
    const unsigned G = gridDim.x;
    unsigned sum, cnt, mine, sp = 0u;
    for (;;) {
        sum = 0u; cnt = 0u; mine = 0u;
#pragma unroll
        for (unsigned j = 0; j < 16; ++j) { const unsigned c = xb_ld(&bar[XB_XCNT(j)]); sum += c; cnt += (c > 0u) ? 1u : 0u; mine = (j == x) ? c : mine; }
        if (sum == G) break;
        __builtin_amdgcn_s_sleep(1);
        if ((++sp & 255u) == 0u) { if (xb_ld(&bar[XB_TMO])) break; if (sp > XB_SPIN_CAP) { atomicAdd(&bar[XB_TMO], 1u); break; } }
    }
    nloc = mine > 0u ? mine : 1u; nx = cnt > 0u ? cnt : 1u;
}
DEVI void xcd_barrier(unsigned* bar, volatile LAS unsigned* st, int tid) {
    asm volatile("s_waitcnt vmcnt(0)" ::: "memory");
    __syncthreads();
    if (tid == 0) {
        const unsigned x = xb_xcc_id();
        __builtin_amdgcn_s_waitcnt(0);
        unsigned nloc = st[0], nx = st[1];
        if (nloc == 0u) { xcd_barrier_complete(bar, x, nloc, nx); st[0] = nloc; st[1] = nx; }
        const unsigned old = xb_add(&bar[XB_XSUB(x)], 1u);
        const unsigned gen = old / nloc;
        if (old + 1u == (gen + 1u) * nloc) {
            __builtin_amdgcn_fence(__ATOMIC_RELEASE, "agent");
            asm volatile("s_waitcnt vmcnt(0)" ::: "memory");
            const unsigned og = xb_add(&bar[XB_TOP], 1u);
            const unsigned tg = og / nx;
            if (og + 1u == (tg + 1u) * nx) xb_add(&bar[XB_TOPGEN], 1u);
            else XB_SPIN(xb_ld(&bar[XB_TOPGEN]) == tg, bar);
            __builtin_amdgcn_fence(__ATOMIC_ACQUIRE, "agent");
            xb_add(&bar[XB_XGEN(x)], 1u);
            asm volatile("s_waitcnt vmcnt(0)" ::: "memory");
        } else {
            XB_SPIN(xb_ld(&bar[XB_XGEN(x)]) == gen, bar);
            __builtin_amdgcn_fence(__ATOMIC_ACQUIRE, "agent");
            asm volatile("s_waitcnt vmcnt(0)" ::: "memory");
        }
    }
    __syncthreads();
}

DEVI Params ldp() {
#if defined(__HIP_DEVICE_COMPILE__)
    auto kp = (const __attribute__((address_space(4))) Params*)__builtin_amdgcn_kernarg_segment_ptr();
    asm volatile("" : "+s"(kp));
    return *kp;
#else
    return Params{};
#endif
}
__global__ void __launch_bounds__(NTHREADS, 2) mega_fwd(Params p_arg_unused) {
    extern __shared__ __attribute__((aligned(16))) unsigned char shm[];
    cg::grid_group grid = cg::this_grid();
    const int c = blockIdx.x, G = gridDim.x;
    const int wv = __builtin_amdgcn_readfirstlane((int)threadIdx.x >> 6);
    LAS unsigned char* lds = (LAS unsigned char*)shm;
    { const int tid = otid(wv);
      if (tid < 4) ((volatile LAS unsigned*)(lds + XB_ST_OFF))[tid] = 0u;
      __syncthreads();
      if (tid == 0) { const Params p = ldp(); (void)xb_add(&((unsigned*)(p.ws + WS_XBAR))[XB_XCNT(xb_xcc_id())], 1u); } }
#define GRID_BAR() do { const Params pb_ = ldp(); xcd_barrier((unsigned*)(pb_.ws + WS_XBAR), (volatile LAS unsigned*)(lds + XB_ST_OFF), otid(wv)); } while (0)

    { const Params p = ldp(); const int tid = otid(wv); (void)tid;
#ifndef SKIP_MOD
      phase_mod(p, (float*)shm, c, tid);
#endif
#ifndef SKIP_SMALL
      phase_small(p, c, G, tid);
#endif
#ifndef SKIP_CVTF0
      cvt_weights_fourier(p, 0, shm, c, G, tid, WS_WOUT);
      gen_df512(p, c, G, tid);
#endif
    }
    grid.sync();

#pragma nounroll
    for (int layer = 0; layer < 4; ++layer) {
        if ((layer & 1) == 0) {
            const int l = layer >> 1;
            { const Params p = ldp(); const int tid = otid(wv); (void)tid; unsigned char* ws = p.ws;
              const float* xp = layer == 0 ? p.x_prompt : p.out; const float* xs = layer == 0 ? p.x_sample : p.out + (size_t)TP * 1024;
#ifndef SKIP_CVTF1
#endif
#ifndef SKIP_NORMT
              (void)l; norm_phase<true>(p, layer, xp, xs, (bf16_t*)(ws + F_H), (bf16_t*)(ws + F_HTP), nullptr, shm, c, G, tid, layer == 0 ? 0 : 2);
#endif
            }
            GRID_BAR();
            { const Params p = ldp(); const int tid = otid(wv); fft_prepass(p, shm, c, G, tid); }
#ifndef SKIP_DFTP
            { const Params p = ldp(); const int tid = otid(wv); (void)tid; unsigned char* ws = p.ws; DftPSched S{(const char*)(ws + WS_D256), (const char*)(ws + F_HTP), G, c}; EpiDft E{(bf16_t*)(ws + F_HCS), 1};
              pg8::gemm_phase(lds, 256, 256, 256, S, E, wv); }
#endif
#ifndef SKIP_WP
            { const Params p = ldp(); const int tid = otid(wv); (void)tid; unsigned char* ws = p.ws; WpSched S{(const char*)(ws + WS_DC256), (const char*)(ws + WS_WUB), G, c}; EpiWp E{(bf16_t*)(ws + WS_WPQ)};
              pg8::gemm_phase(lds, 256, 256, 2048, S, E, wv); }
#endif
            GRID_BAR();
            { const Params p = ldp(); const int tid = otid(wv); (void)tid; unsigned char* ws = p.ws; Dft2Sched S{(const char*)(ws + WS_DF512), (const char*)(ws + F_Y), G, c}; EpiDft2 E{(bf16_t*)(ws + F_HCS)};
              pg8::gemm_phase(lds, 512, 512, 512, S, E, wv); }
            GRID_BAR();
#ifndef SKIP_FG
            { const Params p = ldp(); const int tid = otid(wv); (void)tid; unsigned char* ws = p.ws; RowSched S{(const char*)(ws + F_H), (const char*)(ws + WS_WG), (size_t)256 * 1024 * 2, (size_t)256 * 1024 * 2, 8, G, c}; EpiSiluStore E{(bf16_t*)(ws + F_G)};
              pg8::gemm_phase(lds, 1024, 1024, 1024, S, E, wv); }
#endif
#ifndef SKIP_FPQ
            { const Params p = ldp(); const int tid = otid(wv); (void)tid; unsigned char* ws = p.ws; RowSched S{(const char*)(ws + F_HCS), (const char*)(ws + WS_WPQ), (size_t)256 * 2048 * 2, (size_t)256 * 2048 * 2, 8, G, c}; EpiMulInplace E{(bf16_t*)(ws + F_G)};
              pg8::gemm_phase(lds, 2048, 2048, 2048, S, E, wv); }
#endif
            GRID_BAR();
#ifndef SKIP_FOUT
            { const Params p = ldp(); const int tid = otid(wv); (void)tid; unsigned char* ws = p.ws;
              const float* xp = layer == 0 ? p.x_prompt : p.out; const float* xs = layer == 0 ? p.x_sample : p.out + (size_t)TP * 1024;
              const size_t wo = WS_WOUT + (size_t)(layer & 1) * 4 * MiB, wo_next = WS_WOUT + (size_t)((layer + 1) & 1) * 4 * MiB;
              EpiOut E{xp, xs, p.out, (const float*)(ws + WS_MOD) + (size_t)layer * 9 * 3072};
              { RowSchedLim S{(const char*)(ws + F_G), (const char*)(ws + wo), (size_t)256 * 2048 * 2, (size_t)256 * 2048 * 2, 4, G, c, 64};
                pg8::gemm_phase(lds, 2048, 2048, 2048, S, E, wv); }
              GRID_BAR();
              int cq = c; asm volatile("" : "+s"(cq));
              if ((cq >> 3) < 8) { RowSchedTail S{(const char*)(ws + F_G), (const char*)(ws + wo), (size_t)256 * 2048 * 2, (size_t)256 * 2048 * 2, c};
                pg8::gemm_phase(lds, 2048, 2048, 2048, S, E, wv); }
              else {
                cvt_weights_attn(p, layer >> 1, shm, ((c >> 3) - 8) * 8 + (c & 7), 192, tid, wo_next); __syncthreads();
                norm_phase<false>(p, layer + 1, p.out, p.out + (size_t)TP * 1024, (bf16_t*)(ws + A_H), nullptr, nullptr, shm, c, G, tid, 1); } }
#endif
            GRID_BAR();
        } else {
            const int j = layer >> 1;
            { const Params p = ldp(); const int tid = otid(wv); (void)tid; unsigned char* ws = p.ws;
#ifndef SKIP_CVTA
#endif
#ifndef SKIP_NORMA
              norm_phase<false>(p, layer, p.out, p.out + (size_t)TP * 1024, (bf16_t*)(ws + A_H), nullptr, nullptr, shm, c, G, tid, 2);
#endif
            }
            GRID_BAR();
#pragma nounroll
            for (int hh = 0; hh < 2; ++hh) {
                { const Params p = ldp(); const int tid = otid(wv); (void)tid; unsigned char* ws = p.ws;
#ifndef SKIP_CACHE
                  cvt_cache(p, j, hh, c, G, tid);
#endif
#ifndef SKIP_AIN
                  RowSched S{(const char*)(ws + A_H), (const char*)(ws + WS_WATT) + (size_t)hh * 3072 * 1024 * 2, (size_t)256 * 1024 * 2, (size_t)256 * 1024 * 2, 12, G, c};
                  EpiAttnIn E{(bf16_t*)(ws + A_Q), (bf16_t*)(ws + A_K), (bf16_t*)(ws + A_V), p.out + (size_t)TT * 1024, p.out + (size_t)TT * 1024 + (size_t)16 * 2 * 256 * 2048,
                              (const float*)(ws + WS_COS), (const float*)(ws + WS_SIN), hh, j};
                  pg8::gemm_phase(lds, 1024, 1024, 1024, S, E, wv);
#endif
                }
                GRID_BAR();
#ifndef SKIP_ATT
                { const Params p = ldp(); const int tid = otid(wv); (void)tid; attn_phase(p, j, hh, shm, c, G, wv); }
#endif
                if (hh == 1) {
                    const Params p = ldp(); unsigned char* ws = p.ws; const float lam_init = 0.8f - 0.6f * expf(-0.3f * (float)layer);
                    __syncthreads();
                    CombEarlySched S{(const char*)(ws + A_H), (const char*)(ws + WS_WATT) + (size_t)6144 * 1024 * 2, (size_t)256 * 1024 * 2, (size_t)256 * 1024 * 2, c};
                    EpiCombine E{(bf16_t*)(ws + A_DIFF), (const float*)(ws + A_SSQ), p.subln_g + j * 256, 1.f - lam_init};
                    pg8::gemm_phase(lds, 1024, 1024, 1024, S, E, wv);
                }
                GRID_BAR();
            }
#ifndef SKIP_COMB
            { const Params p = ldp(); const int tid = otid(wv); (void)tid; unsigned char* ws = p.ws; const float lam_init = 0.8f - 0.6f * expf(-0.3f * (float)layer);
              CombLateSched S{(const char*)(ws + A_H), (const char*)(ws + WS_WATT) + (size_t)6144 * 1024 * 2, (size_t)256 * 1024 * 2, (size_t)256 * 1024 * 2, c};
              EpiCombine E{(bf16_t*)(ws + A_DIFF), (const float*)(ws + A_SSQ), p.subln_g + j * 256, 1.f - lam_init};
              pg8::gemm_phase(lds, 1024, 1024, 1024, S, E, wv); }
#endif
            GRID_BAR();
#ifndef SKIP_AOUT
            { const Params p = ldp(); const int tid = otid(wv); (void)tid; unsigned char* ws = p.ws;
              const size_t wo = WS_WOUT + (size_t)(layer & 1) * 4 * MiB, wo_next = WS_WOUT + (size_t)((layer + 1) & 1) * 4 * MiB;
              EpiOut E{p.out, p.out + (size_t)TP * 1024, p.out, (const float*)(ws + WS_MOD) + (size_t)layer * 9 * 3072};
              { RowSchedLim S{(const char*)(ws + A_DIFF), (const char*)(ws + wo), (size_t)256 * 2048 * 2, (size_t)256 * 2048 * 2, 4, G, c, 64};
                pg8::gemm_phase(lds, 2048, 2048, 2048, S, E, wv); }
              GRID_BAR();
              int cq = c; asm volatile("" : "+s"(cq));
              if ((cq >> 3) < 8) { RowSchedTail S{(const char*)(ws + A_DIFF), (const char*)(ws + wo), (size_t)256 * 2048 * 2, (size_t)256 * 2048 * 2, c};
                pg8::gemm_phase(lds, 2048, 2048, 2048, S, E, wv); }
              else if (layer + 1 < 4) {
                cvt_weights_fourier(p, (layer + 1) >> 1, shm, ((c >> 3) - 8) * 8 + (c & 7), 192, tid, wo_next); __syncthreads();
                norm_phase<true>(p, layer + 1, p.out, p.out + (size_t)TP * 1024, (bf16_t*)(ws + F_H), (bf16_t*)(ws + F_HTP), nullptr, shm, c, G, tid, 1); }
              else final_norm(p, c, G, tid, 1); }
#endif
            GRID_BAR();
        }
    }
#ifndef SKIP_FIN
    { const Params p = ldp(); const int tid = otid(wv); (void)tid; final_norm(p, c, G, tid, 2); }
#endif
}

extern "C" void kernel_launch(void* const* d_in, const int* in_sizes, int n_in, void* d_out, int out_size, void* d_ws, size_t ws_size, hipStream_t stream) {
    static int grid_blocks = 0;
    if (grid_blocks == 0) {
        if (n_in != 19 || ws_size < WS_NEED) { fprintf(stderr, "kernel_launch: need 19 inputs and %zu bytes of workspace (got %d, %zu)\n", (size_t)WS_NEED, n_in, ws_size); grid_blocks = -1; return; }
        int dev = 0, cus = 0, per_cu = 0;
        hipGetDevice(&dev);
        hipDeviceGetAttribute(&cus, hipDeviceAttributeMultiprocessorCount, dev);
        if (hipFuncSetAttribute((const void*)mega_fwd, hipFuncAttributeMaxDynamicSharedMemorySize, LDS_BYTES) != hipSuccess) { fprintf(stderr, "kernel_launch: hipFuncSetAttribute failed\n"); grid_blocks = -1; return; }
        if (hipOccupancyMaxActiveBlocksPerMultiprocessor(&per_cu, (const void*)mega_fwd, NTHREADS, LDS_BYTES) != hipSuccess || per_cu < 1) { fprintf(stderr, "kernel_launch: occupancy query gives %d\n", per_cu); per_cu = 1; }
        (void)hipGetLastError();
        grid_blocks = cus;
        if (grid_blocks != 256) { fprintf(stderr, "kernel_launch: built for a 256-CU device (got %d CUs)\n", grid_blocks); grid_blocks = -1; return; }
    }
    if (grid_blocks < 0) return;
    Params p{};
    p.x_prompt = (const float*)d_in[0]; p.x_sample = (const float*)d_in[1]; p.cache_k = (const float*)d_in[2]; p.cache_v = (const float*)d_in[3];
    p.c = (const float*)d_in[4]; p.c_ctx = (const float*)d_in[5]; p.norm_g = (const float*)d_in[6]; p.w_ada = (const float*)d_in[7]; p.b_ada = (const float*)d_in[8];
    p.w_in_f = (const float*)d_in[9]; p.w_out_f = (const float*)d_in[10]; p.w_in_a = (const float*)d_in[11]; p.w_out_a = (const float*)d_in[12];
    p.lam_q1 = (const float*)d_in[13]; p.lam_k1 = (const float*)d_in[14]; p.lam_q2 = (const float*)d_in[15]; p.lam_k2 = (const float*)d_in[16];
    p.subln_g = (const float*)d_in[17]; p.final_g = (const float*)d_in[18];
    p.out = (float*)d_out; p.ws = (unsigned char*)d_ws;
    (void)hipMemsetAsync((char*)d_ws + WS_XBAR, 0, XCD_BAR_WORDS * 4, stream);
    void* args[] = {&p};
    hipError_t e = hipLaunchCooperativeKernel((const void*)mega_fwd, dim3(grid_blocks), dim3(NTHREADS), args, LDS_BYTES, stream);
    if (e != hipSuccess) fprintf(stderr, "cooperative launch failed: %s (grid %d)\n", hipGetErrorString(e), grid_blocks);
}
```

```cpp
#include <hip/hip_runtime.h>
#include <hip/hip_cooperative_groups.h>
#include <cstdio>
#include <cstdint>
namespace cg = cooperative_groups;

#define DEVI __device__ __forceinline__
#define LAS __attribute__((address_space(3)))
typedef unsigned short bf16_t;
typedef short bf16x8 __attribute__((ext_vector_type(8)));
typedef short s16x4 __attribute__((ext_vector_type(4)));
typedef float f32x4 __attribute__((ext_vector_type(4)));
typedef float f32x8 __attribute__((ext_vector_type(8)));
typedef float f32x16 __attribute__((ext_vector_type(16)));
typedef unsigned u32x4 __attribute__((ext_vector_type(4)));
typedef unsigned u32x2 __attribute__((ext_vector_type(2)));

constexpr int TP = 4096, TSMP = 32768, TT = 36864;
constexpr int NTHREADS = 512;
constexpr int XB_ST_OFF = 133120;
constexpr int LDS_BYTES = 133136;
constexpr size_t MiB = (size_t)1 << 20;
constexpr size_t WS_MOD = 0;
constexpr size_t WS_LAM = 448 * 1024;
constexpr size_t WS_COS = 452 * 1024;
constexpr size_t WS_SIN = 460 * 1024;
constexpr size_t WS_XBAR = 472 * 1024;
constexpr size_t WS_D256 = 512 * 1024;
constexpr size_t WS_DC256 = 768 * 1024;
constexpr size_t WS_DF512 = 1 * MiB;
constexpr size_t WS_W = 2 * MiB;
constexpr size_t WS_WG = WS_W;
constexpr size_t WS_WPQ = WS_W + 4 * MiB;
constexpr size_t WS_WUB = WS_W + 12 * MiB;
constexpr size_t WS_WATT = WS_W;
constexpr size_t WS_WOUT = WS_W + 16 * MiB;
constexpr size_t WS_ACT = 26 * MiB;
constexpr size_t F_G = WS_ACT;
constexpr size_t F_HTP = WS_ACT + 360 * MiB;
constexpr size_t F_Y = WS_ACT + 8 * MiB;
constexpr size_t F_H = WS_ACT + 144 * MiB;
constexpr size_t F_HCS = WS_ACT + 216 * MiB;
constexpr size_t A_DIFF = WS_ACT;
constexpr size_t A_H = WS_ACT + 144 * MiB;
constexpr size_t A_Q = WS_ACT + 216 * MiB;
constexpr size_t A_K = WS_ACT + 288 * MiB;
constexpr size_t A_V = WS_ACT + 368 * MiB;
constexpr size_t A_SSQ = WS_ACT + 448 * MiB;
constexpr size_t A_STASH = WS_ACT + 451 * MiB;
constexpr size_t WS_NEED = WS_ACT + 467 * MiB;

struct Params {
    const float *x_prompt, *x_sample, *cache_k, *cache_v, *c, *c_ctx, *norm_g, *w_ada, *b_ada, *w_in_f, *w_out_f, *w_in_a, *w_out_a,
        *lam_q1, *lam_k1, *lam_q2, *lam_k2, *subln_g, *final_g;
    float* out; unsigned char* ws;
};

DEVI int otid(int wv) { unsigned z = 0u; asm volatile("" : "+s"(z));
    int t = (wv << 6) | (int)__builtin_amdgcn_mbcnt_hi(~0u, __builtin_amdgcn_mbcnt_lo(~0u, z)); asm volatile("" : "+v"(t)); return t; }
DEVI float shx(float v, int mask, int lane) { return __int_as_float(__builtin_amdgcn_ds_bpermute(((lane ^ mask) & 63) << 2, __float_as_int(v))); }
DEVI float wave_sum(float v, int lane) { v += shx(v, 32, lane); v += shx(v, 16, lane); v += shx(v, 8, lane); v += shx(v, 4, lane); v += shx(v, 2, lane); v += shx(v, 1, lane); return v; }
DEVI unsigned cvt_pk_bf16(float lo, float hi) { unsigned r; asm volatile("v_cvt_pk_bf16_f32 %0, %1, %2" : "=v"(r) : "v"(lo), "v"(hi)); return r; }
DEVI float bf_lo(unsigned w) { return __uint_as_float(w << 16); }
DEVI float bf_hi(unsigned w) { return __uint_as_float(w & 0xffff0000u); }
DEVI float silu_f(float x) { return x * __builtin_amdgcn_rcpf(1.f + __builtin_amdgcn_exp2f(x * -1.4426950408889634f)); }
DEVI int perm32(int rho) { const int n = rho >> 4, i = rho & 15; return 8 * (i >> 2) + 4 * n + (i & 3); }


namespace pg8 {
constexpr int BM = 256, BK = 64, HALF = 128, HTB = HALF * BK * 2, STAGE_BYTES = 8 * HTB;
DEVI int lds_byte(int r, int c) { const int st = (r >> 4) * 2 + (c >> 5), rr = r & 15, cc = c & 31, ob = rr * 64 + cc * 2; return st * 1024 + (ob ^ (((ob >> 9) & 1) << 5)); }
DEVI void stage_rc(int b, int& R, int& C) { const int st = b / 1024, sb = b % 1024, swz = sb ^ (((sb >> 9) & 1) << 5); R = (st >> 1) * 16 + swz / 64; C = (st & 1) * 32 + (swz % 64) / 2; }
struct Unit { const char* A; const char* B; int pm, pn, b, x; };

template <class Epi, class Sched>
DEVI void gemm_phase(LAS unsigned char* lds, int K, int lda, int ldb, const Sched& S, const Epi& E, int wv) {
    asm volatile("" : "+s"(K), "+s"(lda), "+s"(ldb));
    const int tid = otid(wv), wid = __builtin_amdgcn_readfirstlane(tid >> 6), lane = tid & 63, wr = wid >> 2, wc = wid & 3, fr = lane & 15, fq = lane >> 4;
    const int nt = K / BK;
    unsigned voffA[2], voffB[2];
#pragma unroll
    for (int i = 0; i < 2; ++i) { int R, C; stage_rc(tid * 16 + i * 8192, R, C); voffA[i] = (unsigned)(R * lda + C) * 2u; voffB[i] = (unsigned)(R * ldb + C) * 2u; }
    const size_t kstep = (size_t)(BK * 2);
    const size_t hstepA = (size_t)HALF * lda * 2, hstepB = (size_t)HALF * ldb * 2;
    const unsigned ldsw = (unsigned)wid * 1024u;
    const int aoff = lds_byte(wr * 64 + fr, fq * 8), boff = lds_byte(wc * 32 + fr, fq * 8);
#define PG8_SA(b, h) (((b) * 2 + (h)) * HTB)
#define PG8_SB(b, h) ((4 + (b) * 2 + (h)) * HTB)
#define PG8_STAGE(bufoff, gbase, voff) do { _Pragma("unroll") for (int _i = 0; _i < 2; ++_i) \
        __builtin_amdgcn_global_load_lds((const unsigned*)((const char*)(gbase) + (voff)[_i]), (LAS unsigned*)(lds + (bufoff) + ldsw + _i * 8192), 16, 0, 0); } while (0)
#define PG8_LDA(dst, b, h) do { _Pragma("unroll") for (int m = 0; m < 4; ++m) _Pragma("unroll") for (int k = 0; k < 2; ++k) dst[m][k] = *(const LAS bf16x8*)(lds + PG8_SA(b, h) + aoff + m * 2048 + k * 1024); } while (0)
#define PG8_LDB(dst, b, h) do { _Pragma("unroll") for (int n = 0; n < 2; ++n) _Pragma("unroll") for (int k = 0; k < 2; ++k) dst[n][k] = *(const LAS bf16x8*)(lds + PG8_SB(b, h) + boff + n * 2048 + k * 1024); } while (0)
#define PG8_MMA(ai, bj, At, Bt) do { __builtin_amdgcn_s_setprio(1); _Pragma("unroll") for (int m = 0; m < 4; ++m) _Pragma("unroll") for (int n = 0; n < 2; ++n) _Pragma("unroll") for (int k = 0; k < 2; ++k) \
        acc[ai][bj][m][n] = __builtin_amdgcn_mfma_f32_16x16x32_bf16(Bt[n][k], At[m][k], acc[ai][bj][m][n], 0, 0, 0); __builtin_amdgcn_s_setprio(0); } while (0)
#define PG8_WAIT_V(n) asm volatile("s_waitcnt vmcnt(" #n ")" ::: "memory")
#define PG8_WAIT_L(n) asm volatile("s_waitcnt lgkmcnt(" #n ")" ::: "memory")
#define PG8_BAR __builtin_amdgcn_s_barrier()
#define PG8_SCHED __builtin_amdgcn_sched_barrier(0)
    Unit cur, nxt; int ui = 0;
    if (!S.next(0, cur)) return;
    f32x4 acc[2][2][4][2];
#pragma unroll
    for (int a = 0; a < 2; ++a)
#pragma unroll
        for (int b = 0; b < 2; ++b)
#pragma unroll
            for (int m = 0; m < 4; ++m)
#pragma unroll
                for (int n = 0; n < 2; ++n) acc[a][b][m][n] = (f32x4){0.f, 0.f, 0.f, 0.f};
    bf16x8 At[4][2], B0[2][2], B1[2][2];
    const char* cA = cur.A; const char* cB = cur.B;
    PG8_STAGE(PG8_SB(0, 0), cB, voffB); PG8_STAGE(PG8_SA(0, 0), cA, voffA); PG8_STAGE(PG8_SB(0, 1), cB + hstepB, voffB); PG8_STAGE(PG8_SA(0, 1), cA + hstepA, voffA);
    if (wr == 1) PG8_BAR;
    PG8_WAIT_V(4); PG8_BAR;
    PG8_STAGE(PG8_SB(1, 0), cB + kstep, voffB); PG8_STAGE(PG8_SA(1, 0), cA + kstep, voffA); PG8_STAGE(PG8_SB(1, 1), cB + hstepB + kstep, voffB);
    PG8_WAIT_V(6); PG8_BAR;
    for (;;) {
        const bool has_next = S.next(ui + 1, nxt);
        const char* nA = has_next ? nxt.A : cA; const char* nB = has_next ? nxt.B : cB;
        for (int t = 0; t < nt; t += 2) {
            const bool last = (t == nt - 2);
            const char* a1 = cA + (size_t)(t + 1) * kstep;
            const char* a2 = last ? nA : cA + (size_t)(t + 2) * kstep; const char* b2 = last ? nB : cB + (size_t)(t + 2) * kstep;
            const char* a3 = a2 + kstep; const char* b3 = b2 + kstep;
            PG8_LDB(B0, 0, 0); PG8_SCHED; PG8_LDA(At, 0, 0); PG8_STAGE(PG8_SA(1, 1), a1 + hstepA, voffA);
            PG8_WAIT_L(8); PG8_BAR; PG8_WAIT_L(0); PG8_MMA(0, 0, At, B0); PG8_BAR; PG8_SCHED;
            PG8_LDB(B1, 0, 1); PG8_STAGE(PG8_SB(0, 0), b2, voffB);
            PG8_BAR; PG8_WAIT_L(0); PG8_MMA(0, 1, At, B1); PG8_BAR;
            PG8_LDA(At, 0, 1); PG8_STAGE(PG8_SA(0, 0), a2, voffA);
            PG8_BAR; PG8_WAIT_L(0); PG8_MMA(1, 0, At, B0); PG8_BAR; PG8_SCHED;
            PG8_STAGE(PG8_SB(0, 1), b2 + hstepB, voffB);
            PG8_WAIT_V(6); PG8_BAR; PG8_MMA(1, 1, At, B1); PG8_BAR;
            PG8_LDB(B0, 1, 0); PG8_SCHED; PG8_LDA(At, 1, 0); PG8_STAGE(PG8_SA(0, 1), a2 + hstepA, voffA);
            PG8_WAIT_L(8); PG8_BAR; PG8_WAIT_L(0); PG8_MMA(0, 0, At, B0); PG8_BAR; PG8_SCHED;
            PG8_LDB(B1, 1, 1); PG8_STAGE(PG8_SB(1, 0), b3, voffB);
            PG8_BAR; PG8_WAIT_L(0); PG8_MMA(0, 1, At, B1); PG8_BAR;
            PG8_LDA(At, 1, 1); PG8_STAGE(PG8_SA(1, 0), a3, voffA);
            PG8_BAR; PG8_WAIT_L(0); PG8_MMA(1, 0, At, B0); PG8_BAR; PG8_SCHED;
            PG8_STAGE(PG8_SB(1, 1), b3 + hstepB, voffB);
            PG8_WAIT_V(6); PG8_BAR; PG8_MMA(1, 1, At, B1); PG8_BAR;
        }
        E(acc, cur, wr, wc, fr, fq);
        if (!has_next) break;
#pragma unroll
        for (int a = 0; a < 2; ++a)
#pragma unroll
            for (int b = 0; b < 2; ++b)
#pragma unroll
                for (int m = 0; m < 4; ++m)
#pragma unroll
                    for (int n = 0; n < 2; ++n) acc[a][b][m][n] = (f32x4){0.f, 0.f, 0.f, 0.f};
        cur = nxt; cA = nA; cB = nB; ++ui;
    }
    PG8_WAIT_V(0);
    if (wr == 0) PG8_BAR;
    PG8_BAR;
#undef PG8_SA
#undef PG8_SB
#undef PG8_STAGE
#undef PG8_LDA
#undef PG8_LDB
#undef PG8_MMA
#undef PG8_WAIT_V
#undef PG8_WAIT_L
#undef PG8_BAR
#undef PG8_SCHED
}
}
using pg8::Unit;
typedef f32x4 AccT[2][2][4][2];

struct RowSched {
    const char* A; const char* B; size_t astep, bstep; int nN, G, c;
    DEVI bool next(int i, Unit& u) const {
        const int x = c & 7, slot = c >> 3, nb = (G - x + 7) >> 3, per = 18 * nN, q = i * nb + slot;
        if (q >= per) return false;
        const int g4 = q / (4 * nN), rem = q - g4 * 4 * nN, pig = (18 - 4 * g4) < 4 ? (18 - 4 * g4) : 4;
        u.pm = x * 18 + 4 * g4 + rem % pig; u.pn = rem / pig; u.b = 0; u.x = 0;
        u.A = A + (size_t)u.pm * astep; u.B = B + (size_t)u.pn * bstep; return true;
    }
};
struct RowSchedLim {
    const char* A; const char* B; size_t astep, bstep; int nN, G, c, qlim;
    DEVI bool next(int i, Unit& u) const {
        const int x = c & 7, slot = c >> 3, nb = (G - x + 7) >> 3, q = i * nb + slot;
        if (q >= 18 * nN || q >= qlim) return false;
        u.pm = x * 18 + q / nN; u.pn = q % nN; u.b = 0; u.x = 0;
        u.A = A + (size_t)u.pm * astep; u.B = B + (size_t)u.pn * bstep; return true;
    }
};
struct RowSchedTail {
    const char* A; const char* B; size_t astep, bstep; int c;
    DEVI bool next(int i, Unit& u) const {
        const int x = c & 7, slot = c >> 3; if (i > 0 || slot >= 8) return false;
        const int q = 64 + slot; u.pm = x * 18 + (q >> 2); u.pn = q & 3; u.b = 0; u.x = 0;
        u.A = A + (size_t)u.pm * astep; u.B = B + (size_t)u.pn * bstep; return true;
    }
};
struct CombEarlySched {
    const char* A; const char* B; size_t astep, bstep; int c;
    DEVI bool next(int i, Unit& u) const {
        const int x = c & 7, slot = c >> 3; if (i > 0 || slot < 16) return false;
        const int t = slot - 16; u.pm = x * 18 + (t >> 2); u.pn = t & 3; u.b = 0; u.x = 0;
        u.A = A + (size_t)u.pm * astep; u.B = B + (size_t)u.pn * bstep; return true;
    }
};
struct CombLateSched {
    const char* A; const char* B; size_t astep, bstep; int c;
    DEVI bool next(int i, Unit& u) const {
        const int x = c & 7, slot = c >> 3, r = i * 32 + slot; if (r >= 128) return false;
        int pl, h; if (r < 16) { pl = r >> 2; h = 4 + (r & 3); } else { const int rp = r - 16; pl = 4 + (rp >> 3); h = rp & 7; }
        u.pm = x * 18 + pl; u.pn = h; u.b = 0; u.x = 0;
        u.A = A + (size_t)u.pm * astep; u.B = B + (size_t)u.pn * bstep; return true;
    }
};
struct DftSSched {
    const char* D; const char* HT; int G, c;
    DEVI bool next(int i, Unit& u) const {
        const int x = c & 7, slot = c >> 3, nb = (G - x + 7) >> 3, q = i * nb + slot;
        if (q >= 128) return false;
        u.b = x; u.pm = q >> 2; u.pn = q & 3; u.x = 0;
        u.A = D + (size_t)u.pm * 256 * 4096 * 2; u.B = HT + ((size_t)x * 1024 + (size_t)u.pn * 256) * 4096 * 2; return true;
    }
};
struct Dft2Sched {
    const char* DF; const char* Y; int G, c;
    DEVI bool next(int i, Unit& u) const {
        const int x = c & 7, slot = c >> 3, nb = (G - x + 7) >> 3, q = i * nb + slot;
        if (q >= 128) return false;
        u.b = x; u.x = q >> 3; u.pm = (q >> 2) & 1; u.pn = q & 3;
        u.A = DF + (size_t)u.pm * 256 * 512 * 2; u.B = Y + (((size_t)x * 16 + u.x) * 1024 + (size_t)u.pn * 256) * 512 * 2; return true;
    }
};
struct DftPSched {
    const char* D; const char* HT; int G, c;
    DEVI bool next(int i, Unit& u) const {
        const int q = i * G + c; if (q >= 128) return false;
        u.b = q >> 3; u.pm = (q >> 2) & 1; u.pn = q & 3; u.x = 0;
        u.A = D + (size_t)u.pm * 256 * 256 * 2; u.B = HT + ((size_t)u.b * 1024 + (size_t)u.pn * 256) * 256 * 2; return true;
    }
};
struct WpSched {
    const char* DC; const char* WU; int G, c;
    DEVI bool next(int i, Unit& u) const {
        const int q = i * G + ((c + 128) % G); if (q >= 64) return false;
        u.x = q >> 5; u.b = (q >> 2) & 7; u.pn = q & 3; u.pm = 0;
        u.A = DC + (size_t)u.x * 256 * 256 * 2; u.B = WU + ((size_t)u.pn * 256 * 2048 + (size_t)u.b * 256) * 2; return true;
    }
};

struct EpiSiluStore {
    bf16_t* G;
    DEVI void operator()(const AccT& acc, const Unit& u, int wr, int wc, int fr, int fq) const {
        asm volatile("" : "+v"(fr), "+v"(fq));
#pragma unroll
        for (int ai = 0; ai < 2; ++ai)
#pragma unroll
            for (int m = 0; m < 4; ++m) {
                bf16_t* rowp = G + (size_t)(u.pm * 256 + ai * 128 + wr * 64 + m * 16 + fr) * 2048 + u.pn * 256 + wc * 32 + 8 * fq;
#pragma unroll
                for (int bj = 0; bj < 2; ++bj) { const f32x4 v0 = acc[ai][bj][m][0], v1 = acc[ai][bj][m][1];
                    u32x4 w; w.x = cvt_pk_bf16(silu_f(v0[0]), silu_f(v0[1])); w.y = cvt_pk_bf16(silu_f(v0[2]), silu_f(v0[3]));
                    w.z = cvt_pk_bf16(silu_f(v1[0]), silu_f(v1[1])); w.w = cvt_pk_bf16(silu_f(v1[2]), silu_f(v1[3]));
                    *(u32x4*)(rowp + bj * 128) = w; } }
    }
};
struct EpiMulInplace {
    bf16_t* G;
    DEVI void operator()(const AccT& acc, const Unit& u, int wr, int wc, int fr, int fq) const {
        asm volatile("" : "+v"(fr), "+v"(fq));
        bf16_t* base = G + (size_t)(u.pm * 256 + wr * 64 + fr) * 2048 + u.pn * 256 + wc * 32 + 8 * fq;
        u32x4 g[2][4][2];
#pragma unroll
        for (int ai = 0; ai < 2; ++ai)
#pragma unroll
            for (int m = 0; m < 4; ++m)
#pragma unroll
                for (int bj = 0; bj < 2; ++bj) g[ai][m][bj] = *(const u32x4*)(base + (size_t)(ai * 128 + m * 16) * 2048 + bj * 128);
#pragma unroll
        for (int ai = 0; ai < 2; ++ai)
#pragma unroll
            for (int m = 0; m < 4; ++m)
#pragma unroll
                for (int bj = 0; bj < 2; ++bj) { const f32x4 v0 = acc[ai][bj][m][0], v1 = acc[ai][bj][m][1]; const u32x4 gg = g[ai][m][bj]; u32x4 w;
                    w.x = cvt_pk_bf16(v0[0] * bf_lo(gg.x), v0[1] * bf_hi(gg.x)); w.y = cvt_pk_bf16(v0[2] * bf_lo(gg.y), v0[3] * bf_hi(gg.y));
                    w.z = cvt_pk_bf16(v1[0] * bf_lo(gg.z), v1[1] * bf_hi(gg.z)); w.w = cvt_pk_bf16(v1[2] * bf_lo(gg.w), v1[3] * bf_hi(gg.w));
                    *(u32x4*)(base + (size_t)(ai * 128 + m * 16) * 2048 + bj * 128) = w; }
    }
};
struct EpiDft {
    bf16_t* HCS; int prompt;
    DEVI void operator()(const AccT& acc, const Unit& u, int wr, int wc, int fr, int fq) const {
        asm volatile("" : "+v"(fr), "+v"(fq));
        const int part = prompt ? u.pm : (u.pm >> 4);
        const int tok0 = prompt ? u.b * 256 : TP + u.b * 4096 + (u.pm & 15) * 256;
#pragma unroll
        for (int ai = 0; ai < 2; ++ai)
#pragma unroll
            for (int m = 0; m < 4; ++m) {
                bf16_t* rowp = HCS + (size_t)(tok0 + ai * 128 + wr * 64 + m * 16 + fr) * 2048 + part * 1024 + u.pn * 256 + wc * 32 + 8 * fq;
#pragma unroll
                for (int bj = 0; bj < 2; ++bj) { const f32x4 v0 = acc[ai][bj][m][0], v1 = acc[ai][bj][m][1];
                    u32x4 w; w.x = cvt_pk_bf16(v0[0], v0[1]); w.y = cvt_pk_bf16(v0[2], v0[3]); w.z = cvt_pk_bf16(v1[0], v1[1]); w.w = cvt_pk_bf16(v1[2], v1[3]);
                    *(u32x4*)(rowp + bj * 128) = w; } }
    }
};
struct EpiDft2 {
    bf16_t* HCS;
    DEVI void operator()(const AccT& acc, const Unit& u, int wr, int wc, int fr, int fq) const {
        asm volatile("" : "+v"(fr), "+v"(fq));
        const size_t tok0 = (size_t)TP + (size_t)u.b * 4096 + u.x;
#pragma unroll
        for (int ai = 0; ai < 2; ++ai)
#pragma unroll
            for (int m = 0; m < 4; ++m) {
                bf16_t* rowp = HCS + (tok0 + (size_t)16 * (ai * 128 + wr * 64 + m * 16 + fr)) * 2048 + u.pm * 1024 + u.pn * 256 + wc * 32 + 8 * fq;
#pragma unroll
                for (int bj = 0; bj < 2; ++bj) { const f32x4 v0 = acc[ai][bj][m][0], v1 = acc[ai][bj][m][1];
                    u32x4 w; w.x = cvt_pk_bf16(v0[0], v0[1]); w.y = cvt_pk_bf16(v0[2], v0[3]); w.z = cvt_pk_bf16(v1[0], v1[1]); w.w = cvt_pk_bf16(v1[2], v1[3]);
                    *(u32x4*)(rowp + bj * 128) = w; } }
    }
};
struct EpiWp {
    bf16_t* W;
    DEVI void operator()(const AccT& acc, const Unit& u, int wr, int wc, int fr, int fq) const {
        asm volatile("" : "+v"(fr), "+v"(fq));
#pragma unroll
        for (int ai = 0; ai < 2; ++ai)
#pragma unroll
            for (int m = 0; m < 4; ++m) {
                bf16_t* rowp = W + (size_t)(u.b * 256 + ai * 128 + wr * 64 + m * 16 + fr) * 2048 + u.x * 1024 + u.pn * 256 + wc * 32 + 4 * fq;
#pragma unroll
                for (int bj = 0; bj < 2; ++bj)
#pragma unroll
                    for (int n = 0; n < 2; ++n) { const f32x4 v = acc[ai][bj][m][n]; u32x2 w; w.x = cvt_pk_bf16(v[0], v[1]); w.y = cvt_pk_bf16(v[2], v[3]);
                        *(u32x2*)(rowp + bj * 128 + n * 16) = w; } }
    }
};
struct EpiOut {
    const float* xp; const float* xs; float* X; const float* mod;
    DEVI void operator()(const AccT& acc, const Unit& u, int wr, int wc, int fr, int fq) const {
        asm volatile("" : "+v"(fr), "+v"(fq));
        const int tok0 = u.pm * 256; const int b9 = u.pm < 16 ? 0 : 1 + ((u.pm - 16) >> 4);
        const float* src = u.pm < 16 ? xp + (size_t)tok0 * 1024 : xs + (size_t)(tok0 - TP) * 1024;
        float* dst = X + (size_t)tok0 * 1024;
        const int col0 = u.pn * 256 + wc * 32 + 4 * fq;
        const float* gt = mod + b9 * 3072 + 2048 + col0;
        f32x4 gv[2][2];
#pragma unroll
        for (int bj = 0; bj < 2; ++bj)
#pragma unroll
            for (int n = 0; n < 2; ++n) gv[bj][n] = *(const f32x4*)(gt + bj * 128 + n * 16);
#pragma unroll
        for (int ai = 0; ai < 2; ++ai) {
            f32x4 xo[4][2][2];
#pragma unroll
            for (int m = 0; m < 4; ++m)
#pragma unroll
                for (int bj = 0; bj < 2; ++bj)
#pragma unroll
                    for (int n = 0; n < 2; ++n) xo[m][bj][n] = *(const f32x4*)(src + (size_t)(ai * 128 + wr * 64 + m * 16 + fr) * 1024 + col0 + bj * 128 + n * 16);
#pragma unroll
            for (int m = 0; m < 4; ++m)
#pragma unroll
                for (int bj = 0; bj < 2; ++bj)
#pragma unroll
                    for (int n = 0; n < 2; ++n) *(f32x4*)(dst + (size_t)(ai * 128 + wr * 64 + m * 16 + fr) * 1024 + col0 + bj * 128 + n * 16) = xo[m][bj][n] + gv[bj][n] * acc[ai][bj][m][n];
        }
    }
};
struct EpiAttnIn {
    bf16_t* qh; bf16_t* kh; bf16_t* vh; float* nck; float* ncv; const float* cost; const float* sint; int hh, j;
    DEVI void operator()(const AccT& acc, const Unit& u, int wr, int wc, int fr, int fq) const {
        asm volatile("" : "+v"(fr), "+v"(fq));
        const int kind = u.pn >> 2, hl = u.pn & 3; const bool prompt = u.pm < 16;
        const int sb = prompt ? 0 : (u.pm - 16) >> 4, tib = prompt ? 0 : (u.pm - 16) & 15;
        if (kind < 2) {
            const int axis = wc >> 1, w1 = wc & 1;
            const int cbase = hl * 256 + 64 * axis + 16 * w1 + 4 * fq;
            const int cst = hl * 256 + 64 * axis + 16 * w1 + ((fq & 1) ? 32 + 4 * (fq - 1) : 4 * fq);
            f32x4 csT[4], snT[4];
#pragma unroll
            for (int k = 0; k < 4; ++k) { csT[k] = (f32x4){1.f, 1.f, 1.f, 1.f}; snT[k] = (f32x4){0.f, 0.f, 0.f, 0.f};
                if (!prompt && (axis || k < 2)) { const int pos = axis ? (16 * k + fr) : (4 * tib + 2 * k + wr); csT[k] = *(const f32x4*)(cost + pos * 32 + 16 * w1 + 4 * fq); snT[k] = *(const f32x4*)(sint + pos * 32 + 16 * w1 + 4 * fq); } }
#pragma unroll
            for (int ai = 0; ai < 2; ++ai)
#pragma unroll
                for (int m = 0; m < 4; ++m) {
                    const int r = ai * 128 + wr * 64 + m * 16 + fr;
                    const f32x4 cs = axis ? csT[m] : csT[ai], sn = axis ? snT[m] : snT[ai];
                    bf16_t* dst; float* fdst = nullptr;
                    if (kind == 0) dst = qh + (size_t)(u.pm * 256 + r) * 1024 + cst;
                    else if (prompt) { dst = kh + (size_t)(u.pm * 256 + r) * 1024 + cst; fdst = nck + ((size_t)(u.pm * 2 + j) * 256 + r) * 2048 + hh * 1024 + cbase; }
                    else dst = kh + (size_t)TP * 1024 + ((size_t)sb * 4608 + tib * 256 + r) * 1024 + cst;
#pragma unroll
                    for (int bj = 0; bj < 2; ++bj) { const f32x4 v0 = acc[ai][bj][m][0], v1 = acc[ai][bj][m][1];
                        const f32x4 o0 = v0 * cs - v1 * sn, o1 = v1 * cs + v0 * sn;
                        u32x2 a, b; a.x = cvt_pk_bf16(o0[0], o0[1]); a.y = cvt_pk_bf16(o0[2], o0[3]); b.x = cvt_pk_bf16(o1[0], o1[1]); b.y = cvt_pk_bf16(o1[2], o1[3]);
                        { auto r0 = __builtin_amdgcn_permlane16_swap(a.x, b.x, false, false); auto r1 = __builtin_amdgcn_permlane16_swap(a.y, b.y, false, false);
                          u32x4 w = {r0[0], r1[0], r0[1], r1[1]}; *(u32x4*)(dst + bj * 128) = w; }
                        if (fdst) { *(f32x4*)(fdst + bj * 128) = o0; *(f32x4*)(fdst + bj * 128 + 32) = o1; } } }
        } else {
            const int cbase = hl * 256 + wc * 32 + 8 * fq;
#pragma unroll
            for (int ai = 0; ai < 2; ++ai)
#pragma unroll
                for (int m = 0; m < 4; ++m) {
                    const int r = ai * 128 + wr * 64 + m * 16 + fr;
                    bf16_t* dst; float* fdst = nullptr;
                    if (prompt) { dst = vh + (size_t)(u.pm * 256 + r) * 1024 + cbase; fdst = ncv + ((size_t)(u.pm * 2 + j) * 256 + r) * 2048 + hh * 1024 + cbase; }
                    else dst = vh + (size_t)TP * 1024 + ((size_t)sb * 4608 + tib * 256 + r) * 1024 + cbase;
#pragma unroll
                    for (int bj = 0; bj < 2; ++bj) { const f32x4 v0 = acc[ai][bj][m][0], v1 = acc[ai][bj][m][1];
                        u32x4 w; w.x = cvt_pk_bf16(v0[0], v0[1]); w.y = cvt_pk_bf16(v0[2], v0[3]); w.z = cvt_pk_bf16(v1[0], v1[1]); w.w = cvt_pk_bf16(v1[2], v1[3]);
                        *(u32x4*)(dst + bj * 128) = w;
                        if (fdst) { *(f32x4*)(fdst + bj * 128) = v0; *(f32x4*)(fdst + bj * 128 + 4) = v1; } } }
        }
    }
};
struct EpiCombine {
    bf16_t* D; const float* ssq; const float* subln; float mul;
    DEVI void operator()(const AccT& acc, const Unit& u, int wr, int wc, int fr, int fq) const {
        asm volatile("" : "+v"(fr), "+v"(fq));
        const int h = u.pn; const int cb = wc * 32 + 8 * fq;
        f32x4 sg[2][2];
#pragma unroll
        for (int bj = 0; bj < 2; ++bj)
#pragma unroll
            for (int n = 0; n < 2; ++n) sg[bj][n] = *(const f32x4*)(subln + bj * 128 + cb + 4 * n);
        const size_t tokb = (size_t)(u.pm * 256 + wr * 64 + fr);
        bf16_t* base = D + tokb * 2048 + h * 256 + cb;
#pragma unroll
        for (int q = 0; q < 4; ++q) {
            const int ai = q >> 1, mb = (q & 1) * 2;
            u32x4 d[2][2]; float s0[2], s1[2];
#pragma unroll
            for (int mm = 0; mm < 2; ++mm) { const int m = mb + mm; const size_t tok = tokb + ai * 128 + m * 16; s0[mm] = ssq[tok * 16 + 2 * h]; s1[mm] = ssq[tok * 16 + 2 * h + 1];
#pragma unroll
                for (int bj = 0; bj < 2; ++bj) d[mm][bj] = *(const u32x4*)(base + (size_t)(ai * 128 + m * 16) * 2048 + bj * 128); }
#pragma unroll
            for (int mm = 0; mm < 2; ++mm) { const int m = mb + mm;
                const float rn = rsqrtf((s0[mm] + s1[mm]) * (1.f / 256.f) + 1e-6f) * mul;
#pragma unroll
                for (int bj = 0; bj < 2; ++bj) { const f32x4 v0 = acc[ai][bj][m][0], v1 = acc[ai][bj][m][1];
                    const u32x4 dd = d[mm][bj]; const f32x4 g0 = sg[bj][0] * rn, g1 = sg[bj][1] * rn; u32x4 w;
                    w.x = cvt_pk_bf16(bf_lo(dd.x) * g0[0] * silu_f(v0[0]), bf_hi(dd.x) * g0[1] * silu_f(v0[1]));
                    w.y = cvt_pk_bf16(bf_lo(dd.y) * g0[2] * silu_f(v0[2]), bf_hi(dd.y) * g0[3] * silu_f(v0[3]));
                    w.z = cvt_pk_bf16(bf_lo(dd.z) * g1[0] * silu_f(v1[0]), bf_hi(dd.z) * g1[1] * silu_f(v1[1]));
                    w.w = cvt_pk_bf16(bf_lo(dd.w) * g1[2] * silu_f(v1[2]), bf_hi(dd.w) * g1[3] * silu_f(v1[3]));
                    *(u32x4*)(base + (size_t)(ai * 128 + m * 16) * 2048 + bj * 128) = w; } }
        }
    }
};

namespace att {
constexpr int D = 128, KVBLK = 64, LD = 1024;
constexpr float SCALE = 0.088388347648318440f;
constexpr float THR = 8.f;
constexpr int OFF_V = 0, OFF_K = 65536, OFF_XP = 98304, OFF_XMAX = 114688, OFF_WS = 115712, OFF_XL = 117760, SHM_ATTN = 118784;
#define KSWZ(row, colB) ((row) * 256 + ((colB) ^ (((row) & 7) << 4)))
#define SBAR() __builtin_amdgcn_sched_barrier(0)
DEVI int crow(int r, int hi) { return (r & 3) + 8 * (r >> 2) + 4 * hi; }
DEVI void qkt_half(f32x16& p, const char* Ks, const bf16x8* qr, int krow, int hi) {
    bf16x8 kf[8];
#pragma unroll
    for (int d0 = 0; d0 < 8; ++d0) { const int cb = (d0 * 16 + hi * 8) * 2; kf[d0] = *reinterpret_cast<const bf16x8*>(Ks + KSWZ(krow, cb)); }
    SBAR();
    p = f32x16{};
#pragma unroll
    for (int d0 = 0; d0 < 8; ++d0) p = __builtin_amdgcn_mfma_f32_32x32x16_bf16(kf[d0], qr[d0], p, 0, 0, 0);
}
DEVI int v_st(int k, int c) { const int kk = (k & ~0xC) | ((k & 4) << 1) | ((k & 8) >> 1); return ((kk >> 3) * 4 + (c >> 5)) * 512 + ((kk & 7) * 32 + (c & 31)) * 2; }
DEVI int v_rd_base(int lane) { return ((lane & 3) << 3) | (((lane >> 2) & 3) << 6) | (((lane >> 4) & 1) << 5) | (((lane >> 5) & 1) << 8); }
constexpr int v_rd_off(int d0, int ks, int half) { return d0 * 512 + ks * 4096 + half * 2048; }
template <int OFF> DEVI s16x4 tr_read(int vb) {
    s16x4 r; asm volatile("ds_read_b64_tr_b16 %0, %1 offset:%2" : "=&v"(r) : "v"(vb), "i"(OFF) : "memory"); return r;
}
struct VFrag { s16x4 l0, h0, l1, h1, l2, h2, l3, h3; };
template <int D0> DEVI void pv_reads(VFrag& f, int vb) {
    f.l0 = tr_read<v_rd_off(D0, 0, 0)>(vb); f.h0 = tr_read<v_rd_off(D0, 0, 1)>(vb); f.l1 = tr_read<v_rd_off(D0, 1, 0)>(vb); f.h1 = tr_read<v_rd_off(D0, 1, 1)>(vb);
    f.l2 = tr_read<v_rd_off(D0, 2, 0)>(vb); f.h2 = tr_read<v_rd_off(D0, 2, 1)>(vb); f.l3 = tr_read<v_rd_off(D0, 3, 0)>(vb); f.h3 = tr_read<v_rd_off(D0, 3, 1)>(vb);
}
DEVI void pv_mma(f32x16& od, const VFrag& f, bf16x8 pa0, bf16x8 pa1, bf16x8 pa2, bf16x8 pa3) {
#define PK(L, H) (bf16x8){L[0], L[1], L[2], L[3], H[0], H[1], H[2], H[3]}
    od = __builtin_amdgcn_mfma_f32_32x32x16_bf16(pa0, PK(f.l0, f.h0), od, 0, 0, 0);
    od = __builtin_amdgcn_mfma_f32_32x32x16_bf16(pa1, PK(f.l1, f.h1), od, 0, 0, 0);
    od = __builtin_amdgcn_mfma_f32_32x32x16_bf16(pa2, PK(f.l2, f.h2), od, 0, 0, 0);
    od = __builtin_amdgcn_mfma_f32_32x32x16_bf16(pa3, PK(f.l3, f.h3), od, 0, 0, 0);
#undef PK
}
DEVI void pv_d0(f32x16* o, int vb, bf16x8 pa0, bf16x8 pa1, bf16x8 pa2, bf16x8 pa3) {
    VFrag fa, fb;
    pv_reads<0>(fa, vb); pv_reads<1>(fb, vb);
    asm volatile("s_waitcnt lgkmcnt(8)" ::: "memory"); SBAR();
    pv_mma(o[0], fa, pa0, pa1, pa2, pa3); SBAR();
    pv_reads<2>(fa, vb);
    asm volatile("s_waitcnt lgkmcnt(8)" ::: "memory"); SBAR();
    pv_mma(o[1], fb, pa0, pa1, pa2, pa3); SBAR();
    pv_reads<3>(fb, vb);
    asm volatile("s_waitcnt lgkmcnt(8)" ::: "memory"); SBAR();
    pv_mma(o[2], fa, pa0, pa1, pa2, pa3); SBAR();
    asm volatile("s_waitcnt lgkmcnt(0)" ::: "memory"); SBAR();
    pv_mma(o[3], fb, pa0, pa1, pa2, pa3);
}
DEVI float own_max(const f32x16& p) {
    float pm = p[0];
#pragma unroll
    for (int r = 1; r < 16; ++r) pm = fmaxf(pm, p[r]);
    auto rr = __builtin_amdgcn_permlane32_swap(__float_as_uint(pm), __float_as_uint(pm), false, false);
    return fmaxf(__uint_as_float(rr[0]), __uint_as_float(rr[1]));
}
DEVI void sm_finish(f32x16& p, float pmax, float& m_reg, float& l_reg, float& alpha, bf16x8& f0, bf16x8& f1) {
    constexpr float C = SCALE * 1.4426950408889634f;
    float mn;
    if (__builtin_expect(__all(pmax - m_reg <= THR / SCALE), 1)) { mn = m_reg; alpha = 1.f; }
    else { mn = fmaxf(m_reg, pmax); alpha = __builtin_amdgcn_exp2f((m_reg - mn) * C); m_reg = mn; }
    const float mnC = -mn * C;
#pragma unroll
    for (int r = 0; r < 16; ++r) p[r] = __builtin_amdgcn_exp2f(fmaf(p[r], C, mnC));
    float ps = 0;
#pragma unroll
    for (int r = 0; r < 16; ++r) ps += p[r];
    { auto rr = __builtin_amdgcn_permlane32_swap(__float_as_uint(ps), __float_as_uint(ps), false, false);
      ps = __uint_as_float(rr[0]) + __uint_as_float(rr[1]); }
    l_reg = l_reg * alpha + ps;
#define PK4(P, BASE, OUT) do { unsigned a0 = cvt_pk_bf16(P[BASE + 0], P[BASE + 1]), a1 = cvt_pk_bf16(P[BASE + 2], P[BASE + 3]);   \
    unsigned b0 = cvt_pk_bf16(P[BASE + 4], P[BASE + 5]), b1 = cvt_pk_bf16(P[BASE + 6], P[BASE + 7]);                              \
    auto r0 = __builtin_amdgcn_permlane32_swap(a0, b0, false, false); auto r1 = __builtin_amdgcn_permlane32_swap(a1, b1, false, false); \
    u32x4 w = {r0[0], r1[0], r0[1], r1[1]}; OUT = *reinterpret_cast<bf16x8*>(&w); } while (0)
    PK4(p, 0, f0); PK4(p, 8, f1);
#undef PK4
}

DEVI void attn_run(const bf16_t* __restrict__ Qb, const bf16_t* __restrict__ Kh, const bf16_t* __restrict__ Vh, int seq, char* lds, f32x16 (&o)[4], int wv) {
    const int tid = otid(wv), wid = tid >> 6, lane = tid & 63, r32 = lane & 31, hi = lane >> 5, g = wid >> 1, vh = wid & 1;
    char* V_lds = lds + OFF_V; char* K_lds = lds + OFF_K; char* xP = lds + OFF_XP;
    float* xmax = (float*)(lds + OFF_XMAX); float* xl = (float*)(lds + OFF_XL);
    float* al_l = (float*)(lds + OFF_WS) + wid * 64;
    float m_reg = -1e30f, l_reg = 0; bf16x8 qr[8];
#pragma unroll
    for (int d = 0; d < 4; ++d) o[d] = f32x16{};
    const bf16_t* Qw = Qb + (long)(g * 32 + r32) * LD + hi * 8;
#pragma unroll
    for (int d0 = 0; d0 < 8; ++d0) qr[d0] = *reinterpret_cast<const bf16x8*>(Qw + d0 * 16);
    const int sr = tid >> 4, sc = (tid & 15) * 8, vst0 = v_st(sr, sc), vst1 = v_st(32 + sr, sc);
    const int vb0 = (int)(uintptr_t)V_lds + vh * 16384 + v_rd_base(lane);
    const int krow = 32 * vh + r32;
    const int xp_own = (wid * 2) * 1024 + lane * 16, xp_oth = ((wid ^ 1) * 2) * 1024 + lane * 16;
    bf16x8 sva0, sva1, svc0, svc1, sks0, sks1;
#define SLOAD(k0) do { const bf16_t* vp_ = &Vh[(long)((k0) + sr) * LD + sc]; const bf16_t* kp_ = &Kh[(long)((k0) + sr) * LD + sc]; \
    sva0 = *reinterpret_cast<const bf16x8*>(vp_); sva1 = *reinterpret_cast<const bf16x8*>(vp_ + 32 * LD); \
    svc0 = *reinterpret_cast<const bf16x8*>(vp_ + 128); svc1 = *reinterpret_cast<const bf16x8*>(vp_ + 32 * LD + 128); \
    sks0 = *reinterpret_cast<const bf16x8*>(kp_); sks1 = *reinterpret_cast<const bf16x8*>(kp_ + 32 * LD); } while (0)
#define SWRITE(b) do { char* vd_ = V_lds + (b) * 32768; \
    *(bf16x8*)(vd_ + vst0) = sva0; *(bf16x8*)(vd_ + vst1) = sva1; *(bf16x8*)(vd_ + 16384 + vst0) = svc0; *(bf16x8*)(vd_ + 16384 + vst1) = svc1; \
    const int kc = sc * 2; *(bf16x8*)(K_lds + (b) * 16384 + KSWZ(sr, kc)) = sks0; *(bf16x8*)(K_lds + (b) * 16384 + KSWZ(32 + sr, kc)) = sks1; } while (0)
#define RESC(a) do { if (__any((a) < 1.f)) { if (hi == 0) al_l[r32] = (a); asm volatile("s_waitcnt lgkmcnt(0)" ::: "memory"); \
    _Pragma("unroll") for (int d = 0; d < 4; ++d) _Pragma("unroll") for (int r = 0; r < 16; ++r) o[d][r] *= al_l[crow(r, hi)]; } } while (0)
#define ATT_STEP(BUF, WRITEC, LOADC, LOADK) do { \
    SBAR(); qkt_half(p, K_lds + (BUF) * 16384, qr, krow, hi); \
    pf0 = *(const bf16x8*)(xP + xp_oth); pf1 = *(const bf16x8*)(xP + xp_oth + 1024); SBAR(); \
    pv_d0(o, vb0 + (1 - (BUF)) * 32768, vh ? pf0 : f0, vh ? pf1 : f1, vh ? f0 : pf0, vh ? f1 : pf1); SBAR(); \
    pm = own_max(p); if (hi == 0) xmax[wid * 32 + r32] = pm; \
    __syncthreads(); \
    if (WRITEC) { SWRITE(1 - (BUF)); if (LOADC) SLOAD(LOADK); } \
    { const float pmax = fmaxf(pm, xmax[(wid ^ 1) * 32 + r32]); sm_finish(p, pmax, m_reg, l_reg, alpha, f0, f1); } \
    *(bf16x8*)(xP + xp_own) = f0; *(bf16x8*)(xP + xp_own + 1024) = f1; \
    RESC(alpha); __syncthreads(); } while (0)
    f32x16 p; float pm, alpha; bf16x8 f0, f1, pf0, pf1; const int NT = seq / KVBLK;
    SLOAD(0); asm volatile("s_waitcnt vmcnt(0)" ::: "memory"); SWRITE(0); SLOAD(KVBLK); __syncthreads();
    qkt_half(p, K_lds, qr, krow, hi);
    pm = own_max(p); if (hi == 0) xmax[wid * 32 + r32] = pm;
    __syncthreads();
    SWRITE(1); if (2 < NT) SLOAD(2 * KVBLK);
    { const float pmax = fmaxf(pm, xmax[(wid ^ 1) * 32 + r32]); sm_finish(p, pmax, m_reg, l_reg, alpha, f0, f1); }
    *(bf16x8*)(xP + xp_own) = f0; *(bf16x8*)(xP + xp_own + 1024) = f1;
    __syncthreads();
    for (int j = 1; j + 1 < NT; j += 2) {
        ATT_STEP(1, true, true, (j + 2) * KVBLK);
        ATT_STEP(0, true, (j + 3 < NT), (j + 3) * KVBLK);
    }
    ATT_STEP(1, false, false, 0);
    pf0 = *(const bf16x8*)(xP + xp_oth); pf1 = *(const bf16x8*)(xP + xp_oth + 1024);
    pv_d0(o, vb0 + 32768, vh ? pf0 : f0, vh ? pf1 : f1, vh ? f0 : pf0, vh ? f1 : pf1);
    if (hi == 0) xl[wid * 32 + r32] = l_reg;
    __syncthreads();
#pragma unroll
    for (int r = 0; r < 16; ++r) { const int rw = crow(r, hi); const float rl = __builtin_amdgcn_rcpf(xl[wid * 32 + rw] + xl[(wid ^ 1) * 32 + rw]);
#pragma unroll
        for (int d = 0; d < 4; ++d) o[d][r] *= rl; }
    __syncthreads();
#undef SLOAD
#undef SWRITE
#undef SWAIT
#undef RESC
#undef ATT_STEP
}

DEVI void attn_item(const bf16_t* Q0, const bf16_t* K0, const bf16_t* V, int seq, float lam, bf16_t* diffp, float* ssqp, char* lds, unsigned* stash, int wv) {
    asm volatile("" : "+s"(seq));
    {
        f32x16 o[4];
        attn_run(Q0, K0, V, seq, lds, o, wv);
        const int tid = otid(wv);
#pragma unroll
        for (int d = 0; d < 4; ++d)
#pragma unroll
            for (int r = 0; r < 8; ++r) stash[(d * 8 + r) * 512 + tid] = cvt_pk_bf16(o[d][2 * r], o[d][2 * r + 1]);
    }
    asm volatile("" : "+s"(seq));
    {
        f32x16 o[4];
        attn_run(Q0 + 128, K0 + 128, V, seq, lds, o, wv);
        const int tid = otid(wv);
        const int wid = tid >> 6, lane = tid & 63, r32 = lane & 31, hi = lane >> 5, g = wid >> 1, vh = wid & 1;
        float ss[16];
#pragma unroll
        for (int r = 0; r < 16; ++r) ss[r] = 0.f;
#pragma unroll
        for (int d = 0; d < 4; ++d)
#pragma unroll
            for (int r = 0; r < 8; ++r) { const unsigned w = stash[(d * 8 + r) * 512 + tid];
                o[d][2 * r] = bf_lo(w) - lam * o[d][2 * r]; o[d][2 * r + 1] = bf_hi(w) - lam * o[d][2 * r + 1];
                ss[2 * r] += o[d][2 * r] * o[d][2 * r]; ss[2 * r + 1] += o[d][2 * r + 1] * o[d][2 * r + 1]; }
#pragma unroll
        for (int r = 0; r < 16; ++r) { float v = ss[r]; v += shx(v, 16, lane); v += shx(v, 8, lane); v += shx(v, 4, lane); v += shx(v, 2, lane); v += shx(v, 1, lane); ss[r] = v; }
        if (r32 == 0) {
#pragma unroll
            for (int r = 0; r < 16; ++r) ssqp[(size_t)(g * 32 + crow(r, hi)) * 16 + vh] = ss[r];
        }
        const bool oddl = (lane & 1) != 0;
#pragma unroll
        for (int r2 = 0; r2 < 8; ++r2) { bf16_t* rp = diffp + (size_t)(g * 32 + crow(2 * r2 + (oddl ? 1 : 0), hi)) * 2048 + vh * 128 + (r32 & ~1);
#pragma unroll
            for (int d = 0; d < 4; ++d) { const float snd = oddl ? o[d][2 * r2] : o[d][2 * r2 + 1];
                const float rcv = __int_as_float(__builtin_amdgcn_mov_dpp(__float_as_int(snd), 0xB1, 0xF, 0xF, true));
                *(unsigned*)(rp + d * 32) = oddl ? cvt_pk_bf16(rcv, o[d][2 * r2 + 1]) : cvt_pk_bf16(o[d][2 * r2], rcv); } }
    }
}
}

DEVI void phase_mod(const Params& p, float* sl, int c, int tid) {
    if (c >= 192) return;
    float* scond = sl; float* red = sl + 9 * 1024;
    for (int idx = tid; idx < 9 * 1024; idx += NTHREADS) { const int b = idx >> 10, k = idx & 1023; const float v = b == 0 ? p.c_ctx[k] : p.c[(b - 1) * 1024 + k]; scond[idx] = silu_f(v); }
    __syncthreads();
    const int i = c / 48, n0 = (c % 48) * 64, col = tid & 63, kg = tid >> 6;
    const float* w = p.w_ada + (size_t)i * 1024 * 3072 + n0 + col;
    float acc[9];
#pragma unroll
    for (int b = 0; b < 9; ++b) acc[b] = 0.f;
#pragma unroll 8
    for (int k = kg; k < 1024; k += 8) { const float wv = w[(size_t)k * 3072];
#pragma unroll
        for (int b = 0; b < 9; ++b) acc[b] += scond[b * 1024 + k] * wv; }
#pragma unroll
    for (int b = 0; b < 9; ++b) red[(kg * 9 + b) * 64 + col] = acc[b];
    __syncthreads();
    float* mod = (float*)(p.ws + WS_MOD);
    for (int idx = tid; idx < 576; idx += NTHREADS) { const int b = idx >> 6, cc = idx & 63; float s = 0.f;
#pragma unroll
        for (int g = 0; g < 8; ++g) s += red[(g * 9 + b) * 64 + cc];
        mod[(size_t)(i * 9 + b) * 3072 + n0 + cc] = s + p.b_ada[i * 3072 + n0 + cc]; }
    __syncthreads();
}
DEVI void phase_small(const Params& p, int c, int G, int tid) {
    if (c == 192 % G && tid < 64) {
        for (int j = 0; j < 2; ++j) {
            float a = p.lam_q1[j * 128 + tid] * p.lam_k1[j * 128 + tid] + p.lam_q1[j * 128 + 64 + tid] * p.lam_k1[j * 128 + 64 + tid];
            float b = p.lam_q2[j * 128 + tid] * p.lam_k2[j * 128 + tid] + p.lam_q2[j * 128 + 64 + tid] * p.lam_k2[j * 128 + 64 + tid];
            a = wave_sum(a, tid); b = wave_sum(b, tid);
            const float lam_init = 0.8f - 0.6f * expf(-0.3f * (float)(2 * j + 1));
            if (tid == 0) ((float*)(p.ws + WS_LAM))[j] = expf(a) - expf(b) + lam_init;
        }
    }
    if (c == 193 % G) {
        for (int e = tid; e < 2048; e += NTHREADS) { const int pos = e >> 5, idx = e & 31;
            const float inv = exp2f(-(float)idx * (13.287712379549449f / 32.f));
            const float rev = (float)pos * inv * 0.15915494309189535f;
            ((float*)(p.ws + WS_COS))[e] = __builtin_amdgcn_cosf(rev); ((float*)(p.ws + WS_SIN))[e] = __builtin_amdgcn_sinf(rev); }
    }
    for (int e = c * NTHREADS + tid; e < 512 * 256 + 2 * 256 * 256; e += G * NTHREADS) {
        if (e < 512 * 256) { const int r = e >> 8, m = e & 255, ph = ((r & 255) * m) & 255; const float rev = (float)ph * (1.f / 256.f);
            const float v = (r < 256 ? __builtin_amdgcn_cosf(rev) : __builtin_amdgcn_sinf(rev)) * (1.f / 16.f);
            ((bf16_t*)(p.ws + WS_D256))[e] = (bf16_t)(cvt_pk_bf16(v, 0.f) & 0xffffu);
        } else { const int e2 = e - 512 * 256, part = e2 >> 16, s = (e2 >> 8) & 255, cc = e2 & 255; const int n = (s & ~31) | perm32(s & 31);
            const int ph = (n * cc) & 255; const float rev = (float)ph * (1.f / 256.f);
            const float v = (part == 0 ? __builtin_amdgcn_cosf(rev) : -__builtin_amdgcn_sinf(rev)) * (1.f / 16.f);
            ((bf16_t*)(p.ws + WS_DC256))[e2] = (bf16_t)(cvt_pk_bf16(v, 0.f) & 0xffffu); }
    }
}
DEVI void gen_df512(const Params& p, int c, int G, int tid) {
    bf16_t* DF = (bf16_t*)(p.ws + WS_DF512);
    for (int e = c * NTHREADS + tid; e < 512 * 512; e += G * NTHREADS) {
        const int r = e >> 9, kk = e & 511, ph = ((r & 255) * (kk & 255)) & 255; const float rev = (float)ph * (1.f / 256.f);
        const float cs = __builtin_amdgcn_cosf(rev), sn = __builtin_amdgcn_sinf(rev);
        const float v = (r < 256 ? (kk < 256 ? cs : sn) : (kk < 256 ? sn : -cs)) * (1.f / 64.f);
        DF[e] = (bf16_t)(cvt_pk_bf16(v, 0.f) & 0xffffu);
    }
}
constexpr float kC16[16] = {1.f, 0.92387953251f, 0.70710678119f, 0.38268343237f, 0.f, -0.38268343237f, -0.70710678119f, -0.92387953251f,
                            -1.f, -0.92387953251f, -0.70710678119f, -0.38268343237f, 0.f, 0.38268343237f, 0.70710678119f, 0.92387953251f};
DEVI void fft_prepass(const Params& p, unsigned char* ldsg, int c, int G, int tid) {
    const bf16_t* H = (const bf16_t*)(p.ws + F_H); bf16_t* Y = (bf16_t*)(p.ws + F_Y);
    const int p2 = tid & 31, cg = tid >> 5;
    for (int tile = c; tile < 1024; tile += G) {
        const int b = tile >> 7, n2_0 = ((tile >> 5) & 3) * 64, ch0 = (tile & 31) * 32;
#pragma unroll
        for (int it = 0; it < 8; ++it) { const int q = tid + NTHREADS * it, row = q >> 2, part = q & 3, n1 = row >> 6, n2l = row & 63;
            const bf16_t* src = H + ((size_t)TP + (size_t)b * 4096 + 256 * n1 + n2_0 + n2l) * 1024 + ch0 + part * 8;
            const u32x4 v = *(const u32x4*)src; u32x2* d = (u32x2*)(ldsg + row * 72 + part * 16); d[0] = (u32x2){v.x, v.y}; d[1] = (u32x2){v.z, v.w}; }
        __syncthreads();
#pragma unroll 1
        for (int chsel = 0; chsel < 2; ++chsel) {
            const int chl = 2 * cg + chsel;
            float yr[2][16], yi[2][16];
#pragma unroll
            for (int e = 0; e < 2; ++e) {
                const int n2l = 2 * p2 + e; float x[16];
#pragma unroll
                for (int n1 = 0; n1 < 16; ++n1) x[n1] = __uint_as_float((unsigned)(*(const bf16_t*)(ldsg + (n1 * 64 + n2l) * 72 + chl * 2)) << 16);
                float sm[8], df[8];
#pragma unroll
                for (int n = 1; n < 8; ++n) { sm[n] = x[n] + x[16 - n]; df[n] = x[n] - x[16 - n]; }
                float Ar[9], Ai[9];
#pragma unroll
                for (int k = 0; k <= 8; ++k) { float ar = x[0] + ((k & 1) ? -x[8] : x[8]), ai = 0.f;
#pragma unroll
                    for (int n = 1; n < 8; ++n) { ar += sm[n] * kC16[(n * k) & 15]; ai += df[n] * kC16[(n * k + 12) & 15]; }
                    Ar[k] = ar; Ai[k] = ai; }
                const int n2 = n2_0 + n2l;
#pragma unroll
                for (int k1 = 0; k1 < 16; ++k1) { const float ar = Ar[k1 <= 8 ? k1 : 16 - k1], ai = k1 <= 8 ? Ai[k1] : -Ai[16 - k1];
                    const float rev = (float)(n2 * k1) * (1.f / 4096.f); const float cs = __builtin_amdgcn_cosf(rev), sn = __builtin_amdgcn_sinf(rev);
                    yr[e][k1] = ar * cs - ai * sn; yi[e][k1] = -(ar * sn + ai * cs); }
            }
            const int ch = ch0 + chl, slot = (ch & ~31) | (16 * ((ch >> 2) & 1) + 4 * ((ch & 31) >> 3) + (ch & 3));
            bf16_t* yb = Y + (((size_t)b * 16) * 1024 + slot) * 512 + n2_0 + 2 * p2;
#pragma unroll
            for (int k1 = 0; k1 < 16; ++k1) { *(unsigned*)(yb + (size_t)k1 * 1024 * 512) = cvt_pk_bf16(yr[0][k1], yr[1][k1]); *(unsigned*)(yb + (size_t)k1 * 1024 * 512 + 256) = cvt_pk_bf16(yi[0][k1], yi[1][k1]); }
        }
        __syncthreads();
    }
}
DEVI int sigma64(int kind, int s) { return kind == 0 ? s : (kind == 1 ? ((s & 32) | perm32(s & 31)) : (32 * ((s >> 4) & 1) + 16 * (s >> 5) + (s & 15))); }
DEVI void cvt_tile(const float* src, int lds_, int k0, int c0, bf16_t* dst, int ldd, int r0, int kind, bf16_t* tl, int lane) {
    const int cl = (lane & 15) * 4, kr = lane >> 4;
#pragma unroll
    for (int it = 0; it < 16; ++it) { const int k = kr + 4 * it; const f32x4 v = *(const f32x4*)(src + (size_t)(k0 + k) * lds_ + c0 + cl);
        u32x2 w; w.x = cvt_pk_bf16(v[0], v[1]); w.y = cvt_pk_bf16(v[2], v[3]); *(u32x2*)(tl + k * 68 + cl) = w; }
    __builtin_amdgcn_fence(__ATOMIC_RELEASE, "wavefront"); __builtin_amdgcn_wave_barrier(); __builtin_amdgcn_fence(__ATOMIC_ACQUIRE, "wavefront");
    const int q = lane & 7, sr = lane >> 3;
#pragma unroll
    for (int it = 0; it < 8; ++it) { const int s = sr + 8 * it, col = sigma64(kind, s); unsigned e[8];
#pragma unroll
        for (int k = 0; k < 8; ++k) e[k] = tl[(8 * q + k) * 68 + col];
        u32x4 w; w.x = e[0] | (e[1] << 16); w.y = e[2] | (e[3] << 16); w.z = e[4] | (e[5] << 16); w.w = e[6] | (e[7] << 16);
        *(u32x4*)(dst + (size_t)(r0 + s) * ldd + k0 + 8 * q) = w; }
    __builtin_amdgcn_fence(__ATOMIC_RELEASE, "wavefront"); __builtin_amdgcn_wave_barrier(); __builtin_amdgcn_fence(__ATOMIC_ACQUIRE, "wavefront");
}
DEVI void cvt_weights_fourier(const Params& p, int l, unsigned char* ldsg, int c, int G, int tid, size_t wout_off) {
    const int lane = tid & 63, wid = tid >> 6, gw = c * 8 + wid, nw = G * 8;
    bf16_t* tl = (bf16_t*)(ldsg + wid * 8704);
    const float* win = p.w_in_f + (size_t)l * 1024 * 4096; const float* wout = p.w_out_f + (size_t)l * 2048 * 1024;
    for (int t = gw; t < 512 + 512; t += nw) {
        if (t < 512) { const int rb = t >> 4, kb = t & 15;
            cvt_tile(win, 4096, kb * 64, 2048 + rb * 64, (bf16_t*)(p.ws + WS_WG), 1024, rb * 64, 1, tl, lane);
        } else { const int t2 = t - 512, rb = t2 >> 5, kb = t2 & 31;
            cvt_tile(wout, 1024, kb * 64, rb * 64, (bf16_t*)(p.ws + wout_off), 2048, rb * 64, 0, tl, lane); }
    }
    bf16_t* wub = (bf16_t*)(p.ws + WS_WUB);
    for (int e = c * NTHREADS + tid; e < 1024 * 256; e += G * NTHREADS) { const int k = e >> 8, c8 = (e & 255) * 8;
        const f32x4 a = *(const f32x4*)(win + (size_t)k * 4096 + c8), b = *(const f32x4*)(win + (size_t)k * 4096 + c8 + 4);
        u32x4 w; w.x = cvt_pk_bf16(a[0], a[1]); w.y = cvt_pk_bf16(a[2], a[3]); w.z = cvt_pk_bf16(b[0], b[1]); w.w = cvt_pk_bf16(b[2], b[3]);
        *(u32x4*)(wub + (size_t)k * 2048 + c8) = w; }
}
DEVI void cvt_weights_attn(const Params& p, int j, unsigned char* ldsg, int c, int G, int tid, size_t wout_off) {
    const int lane = tid & 63, wid = tid >> 6, gw = c * 8 + wid, nw = G * 8;
    bf16_t* tl = (bf16_t*)(ldsg + wid * 8704);
    const float* win = p.w_in_a + (size_t)j * 1024 * 8192; const float* wout = p.w_out_a + (size_t)j * 2048 * 1024;
    for (int t = gw; t < 2048 + 512; t += nw) {
        if (t < 2048) { const int rb = t >> 4, kb = t & 15;
            const int tix = rb >> 2, qb = rb & 3; int scol, kind;
            if (tix < 24) { const int hh = tix / 12, kd = (tix % 12) >> 2, hl = tix & 3; scol = kd * 2048 + (hh * 4 + hl) * 256 + 64 * qb; kind = kd < 2 ? 2 : 1; }
            else { scol = 6144 + (tix - 24) * 256 + 64 * qb; kind = 1; }
            cvt_tile(win, 8192, kb * 64, scol, (bf16_t*)(p.ws + WS_WATT), 1024, rb * 64, kind, tl, lane);
        } else { const int t2 = t - 2048, rb = t2 >> 5, kb = t2 & 31;
            cvt_tile(wout, 1024, kb * 64, rb * 64, (bf16_t*)(p.ws + wout_off), 2048, rb * 64, 0, tl, lane); }
    }
}
DEVI int norm_ntiles(int c, int part) { asm volatile("" : "+s"(c)); const int slot = c >> 3; if (slot < 8) return part == 1 ? 0 : 1; if (part == 2) return 0; const int idx = (slot - 8) * 8 + (c & 7); return (512 - idx + 191) / 192; }
DEVI int norm_tile(int c, int i) {
    asm volatile("" : "+s"(c));
    const int slot = c >> 3, x = c & 7;
    if (slot < 8) return ((x * 18 + 16 + (slot & 1)) * 4 + (slot >> 1));
    const int k = (slot - 8) * 8 + x + 192 * i; return (((k & 7) * 18 + ((k >> 3) & 15)) * 4 + (k >> 7));
}
template <bool TRANS>
DEVI void norm_phase(const Params& p, int layer, const float* xp, const float* xs, bf16_t* H, bf16_t* HTp, bf16_t* HTs, unsigned char* ldsg, int c, int G, int tid, int part) {
    const int lane = tid & 63, wid = tid >> 6;
    const float* mod = (const float*)(p.ws + WS_MOD) + (size_t)layer * 9 * 3072;
    const float* g = p.norm_g + layer * 1024;
    const int nti = norm_ntiles(c, part);
    for (int ti = 0; ti < nti; ++ti) {
        const int tile = norm_tile(c, ti);
        const int t0 = tile * 64; const int b9 = t0 < TP ? 0 : 1 + ((t0 - TP) >> 12);
        const float* sh = mod + b9 * 3072; const float* sc = sh + 1024;
        f32x4 gm[4], sv[4];
#pragma unroll
        for (int it = 0; it < 4; ++it) { const int col = 4 * lane + 256 * it; const f32x4 gv = *(const f32x4*)(g + col), scv = *(const f32x4*)(sc + col);
            gm[it] = gv * (scv + 1.f); sv[it] = *(const f32x4*)(sh + col); }
        for (int rr = 0; rr < 8; ++rr) {
            const int row = wid * 8 + rr, t = t0 + row;
            const float* xr = t < TP ? xp + (size_t)t * 1024 : xs + (size_t)(t - TP) * 1024;
            f32x4 v[4]; float ss = 0.f;
#pragma unroll
            for (int it = 0; it < 4; ++it) { v[it] = *(const f32x4*)(xr + 4 * lane + 256 * it); ss += v[it][0] * v[it][0] + v[it][1] * v[it][1] + v[it][2] * v[it][2] + v[it][3] * v[it][3]; }
            ss = wave_sum(ss, lane);
            const float rs = rsqrtf(ss * (1.f / 1024.f) + 1e-6f);
#pragma unroll
            for (int it = 0; it < 4; ++it) { const int col = 4 * lane + 256 * it; const f32x4 h = v[it] * rs * gm[it] + sv[it];
                u32x2 w; w.x = cvt_pk_bf16(h[0], h[1]); w.y = cvt_pk_bf16(h[2], h[3]);
                *(u32x2*)(H + (size_t)t * 1024 + col) = w;
                if (TRANS && t0 < TP) *(u32x2*)(ldsg + ((size_t)row * 1028 + col) * 2) = w; }
        }
        if (TRANS && t0 < TP) {
            __syncthreads();
            const int chunk = tid & 7; bf16_t* dstb = HTp + (size_t)(t0 >> 8) * 1024 * 256 + (t0 & 255); const int ldt = 256;
#pragma unroll 4
            for (int it = 0; it < 16; ++it) { const int srow = (tid >> 3) + 64 * it; const int ch = (srow & ~31) | perm32(srow & 31); unsigned e[8];
#pragma unroll
                for (int k = 0; k < 8; ++k) e[k] = *(const bf16_t*)(ldsg + ((size_t)(8 * chunk + k) * 1028 + ch) * 2);
                u32x4 w; w.x = e[0] | (e[1] << 16); w.y = e[2] | (e[3] << 16); w.z = e[4] | (e[5] << 16); w.w = e[6] | (e[7] << 16);
                *(u32x4*)(dstb + (size_t)srow * ldt + 8 * chunk) = w; }
            __syncthreads();
        }
    }
}
DEVI void final_norm(const Params& p, int c, int G, int tid, int part) {
    const int lane = tid & 63, wid = tid >> 6;
    f32x4 gm[4];
#pragma unroll
    for (int it = 0; it < 4; ++it) gm[it] = *(const f32x4*)(p.final_g + 4 * lane + 256 * it);
    const int nti = norm_ntiles(c, part);
    for (int ti = 0; ti < nti; ++ti) {
        const int tile = norm_tile(c, ti);
        for (int rr = 0; rr < 8; ++rr) {
            const int t = tile * 64 + wid * 8 + rr;
            float* xr = p.out + (size_t)t * 1024; f32x4 v[4]; float ss = 0.f;
#pragma unroll
            for (int it = 0; it < 4; ++it) { v[it] = *(const f32x4*)(xr + 4 * lane + 256 * it); ss += v[it][0] * v[it][0] + v[it][1] * v[it][1] + v[it][2] * v[it][2] + v[it][3] * v[it][3]; }
            ss = wave_sum(ss, lane);
            const float rs = rsqrtf(ss * (1.f / 1024.f) + 1e-6f);
#pragma unroll
            for (int it = 0; it < 4; ++it) *(f32x4*)(xr + 4 * lane + 256 * it) = v[it] * rs * gm[it];
        }
    }
}
DEVI void cvt_cache(const Params& p, int j, int hh, int c, int G, int tid) {
    bf16_t* ks = (bf16_t*)(p.ws + A_K) + (size_t)TP * 1024; bf16_t* vs = (bf16_t*)(p.ws + A_V) + (size_t)TP * 1024;
    for (int e = c * NTHREADS + tid; e < 2 * 8 * 512 * 128; e += G * NTHREADS) {
        const int which = e >> 19, rem = e & ((1 << 19) - 1), b = rem >> 16, pp = (rem >> 7) & 511, ch = (rem & 127) * 8;
        const float* src = (which ? p.cache_v : p.cache_k) + ((size_t)(b * 2 + j) * 512 + pp) * 2048 + hh * 1024 + ch;
        bf16_t* dst = (which ? vs : ks) + ((size_t)b * 4608 + 4096 + pp) * 1024 + ch;
        const f32x4 a = *(const f32x4*)src, bb = *(const f32x4*)(src + 4);
        u32x4 w; w.x = cvt_pk_bf16(a[0], a[1]); w.y = cvt_pk_bf16(a[2], a[3]); w.z = cvt_pk_bf16(bb[0], bb[1]); w.w = cvt_pk_bf16(bb[2], bb[3]);
        *(u32x4*)dst = w;
    }
}
DEVI void attn_phase(const Params& p, int j, int hh, unsigned char* ldsg, int c, int G, int wv) {
    const bf16_t* qh = (const bf16_t*)(p.ws + A_Q); const bf16_t* kh = (const bf16_t*)(p.ws + A_K); const bf16_t* vh = (const bf16_t*)(p.ws + A_V);
    bf16_t* diff = (bf16_t*)(p.ws + A_DIFF); float* ssq = (float*)(p.ws + A_SSQ);
    unsigned* stash = (unsigned*)(p.ws + A_STASH) + (size_t)c * 16384;
    const float lam = ((const float*)(p.ws + WS_LAM))[j];
    const int x = c & 7, slot = c >> 3, nb = (G - x + 7) >> 3;
    const int ns = slot < 128 ? (128 - slot + nb - 1) / nb : 0;
    const int np = c < 128 ? (128 - c + G - 1) / G : 0;
#pragma nounroll
    for (int it = 0; it < ns + np; ++it) {
        const bf16_t *Q0, *K0, *V0; bf16_t* dp; float* sp; int seq;
        if (it < ns) {
            const int q = slot + it * nb, b = x, hl = q >> 5, qb = q & 31, h = hh * 4 + hl;
            const size_t tok0 = (size_t)TP + (size_t)b * 4096 + (size_t)qb * 128;
            Q0 = qh + tok0 * 1024 + hl * 256; K0 = kh + ((size_t)TP + (size_t)b * 4608) * 1024 + hl * 256; V0 = vh + ((size_t)TP + (size_t)b * 4608) * 1024 + hl * 256;
            dp = diff + tok0 * 2048 + h * 256; sp = ssq + tok0 * 16 + 2 * h; seq = 4608;
        } else {
            const int q = c + (it - ns) * G, b = q >> 3, hl = (q >> 1) & 3, qb = q & 1, h = hh * 4 + hl;
            const size_t tok0 = (size_t)b * 256 + (size_t)qb * 128;
            Q0 = qh + tok0 * 1024 + hl * 256; K0 = kh + (size_t)b * 256 * 1024 + hl * 256; V0 = vh + (size_t)b * 256 * 1024 + hl * 256;
            dp = diff + tok0 * 2048 + h * 256; sp = ssq + tok0 * 16 + 2 * h; seq = 256;
        }
        att::attn_item(Q0, K0, V0, seq, lam, dp, sp, (char*)ldsg, stash, wv);
    }
}

#define XB_TMO      128
#define XB_XCNT(j)  (256  + 64 * (j))
#define XB_XSUB(j)  (1280 + 64 * (j))
#define XB_XGEN(j)  (2304 + 64 * (j))
#define XB_TOP      3328
#define XB_TOPGEN   3392
#define XCD_BAR_WORDS 3456
#define XB_SPIN_CAP (1u << 18)
DEVI unsigned xb_ld(unsigned* p)              { return __hip_atomic_load(p, __ATOMIC_RELAXED, __HIP_MEMORY_SCOPE_AGENT); }
DEVI unsigned xb_add(unsigned* p, unsigned v) { return __hip_atomic_fetch_add(p, v, __ATOMIC_RELAXED, __HIP_MEMORY_SCOPE_AGENT); }
DEVI unsigned xb_xcc_id() { return (unsigned)__builtin_amdgcn_s_getreg((3 << 11) | 20) & 0xFu; }
#define XB_SPIN(cond, bar) do { unsigned _sp = 0; while (cond) { __builtin_amdgcn_s_sleep(1); \
    if ((++_sp & 255u) == 0u) { if (xb_ld(&(bar)[XB_TMO])) break; if (_sp > XB_SPIN_CAP) { atomicAdd(&(bar)[XB_TMO], 1u); break; } } } } while (0)
DEVI void xcd_barrier_complete(unsigned* bar, unsigned x, unsigned& nloc, unsigned& nx) {
    const unsigned G = gridDim.x;
    unsigned sum, cnt, mine, sp = 0u;
    for (;;) {
        sum = 0u; cnt = 0u; mine = 0u;
#pragma unroll
        for (unsigned j = 0; j < 16; ++j) { const unsigned c = xb_ld(&bar[XB_XCNT(j)]); sum += c; cnt += (c > 0u) ? 1u : 0u; mine = (j == x) ? c : mine; }
        if (sum == G) break;
        __builtin_amdgcn_s_sleep(1);
        if ((++sp & 255u) == 0u) { if (xb_ld(&bar[XB_TMO])) break; if (sp > XB_SPIN_CAP) { atomicAdd(&bar[XB_TMO], 1u); break; } }
    }
    nloc = mine > 0u ? mine : 1u; nx = cnt > 0u ? cnt : 1u;
}
DEVI void xcd_barrier(unsigned* bar, volatile LAS unsigned* st, int tid) {
    asm volatile("s_waitcnt vmcnt(0)" ::: "memory");
    __syncthreads();
    if (tid == 0) {
        const unsigned x = xb_xcc_id();
        __builtin_amdgcn_s_waitcnt(0);
        unsigned nloc = st[0], nx = st[1];
        if (nloc == 0u) { xcd_barrier_complete(bar, x, nloc, nx); st[0] = nloc; st[1] = nx; }
        const unsigned old = xb_add(&bar[XB_XSUB(x)], 1u);
        const unsigned gen = old / nloc;
        if (old + 1u == (gen + 1u) * nloc) {
            __builtin_amdgcn_fence(__ATOMIC_RELEASE, "agent");
            asm volatile("s_waitcnt vmcnt(0)" ::: "memory");
            const unsigned og = xb_add(&bar[XB_TOP], 1u);
            const unsigned tg = og / nx;
            if (og + 1u == (tg + 1u) * nx) xb_add(&bar[XB_TOPGEN], 1u);
            else XB_SPIN(xb_ld(&bar[XB_TOPGEN]) == tg, bar);
            __builtin_amdgcn_fence(__ATOMIC_ACQUIRE, "agent");
            xb_add(&bar[XB_XGEN(x)], 1u);
            asm volatile("s_waitcnt vmcnt(0)" ::: "memory");
        } else {
            XB_SPIN(xb_ld(&bar[XB_XGEN(x)]) == gen, bar);
            __builtin_amdgcn_fence(__ATOMIC_ACQUIRE, "agent");
            asm volatile("s_waitcnt vmcnt(0)" ::: "memory");
        }
    }
    __syncthreads();
}

DEVI Params ldp() {
#if defined(__HIP_DEVICE_COMPILE__)
    auto kp = (const __attribute__((address_space(4))) Params*)__builtin_amdgcn_kernarg_segment_ptr();
    asm volatile("" : "+s"(kp));
    return *kp;
#else
    return Params{};
#endif
}
__global__ void __launch_bounds__(NTHREADS, 2) mega_fwd(Params p_arg_unused) {
    extern __shared__ __attribute__((aligned(16))) unsigned char shm[];
    cg::grid_group grid = cg::this_grid();
    const int c = blockIdx.x, G = gridDim.x;
    const int wv = __builtin_amdgcn_readfirstlane((int)threadIdx.x >> 6);
    LAS unsigned char* lds = (LAS unsigned char*)shm;
    { const int tid = otid(wv);
      if (tid < 4) ((volatile LAS unsigned*)(lds + XB_ST_OFF))[tid] = 0u;
      __syncthreads();
      if (tid == 0) { const Params p = ldp(); (void)xb_add(&((unsigned*)(p.ws + WS_XBAR))[XB_XCNT(xb_xcc_id())], 1u); } }
#define GRID_BAR() do { const Params pb_ = ldp(); xcd_barrier((unsigned*)(pb_.ws + WS_XBAR), (volatile LAS unsigned*)(lds + XB_ST_OFF), otid(wv)); } while (0)

    { const Params p = ldp(); const int tid = otid(wv); (void)tid;
#ifndef SKIP_MOD
      phase_mod(p, (float*)shm, c, tid);
#endif
#ifndef SKIP_SMALL
      phase_small(p, c, G, tid);
#endif
#ifndef SKIP_CVTF0
      cvt_weights_fourier(p, 0, shm, c, G, tid, WS_WOUT);
      gen_df512(p, c, G, tid);
#endif
    }
    grid.sync();

#pragma nounroll
    for (int layer = 0; layer < 4; ++layer) {
        if ((layer & 1) == 0) {
            const int l = layer >> 1;
            { const Params p = ldp(); const int tid = otid(wv); (void)tid; unsigned char* ws = p.ws;
              const float* xp = layer == 0 ? p.x_prompt : p.out; const float* xs = layer == 0 ? p.x_sample : p.out + (size_t)TP * 1024;
#ifndef SKIP_CVTF1
#endif
#ifndef SKIP_NORMT
              (void)l; norm_phase<true>(p, layer, xp, xs, (bf16_t*)(ws + F_H), (bf16_t*)(ws + F_HTP), nullptr, shm, c, G, tid, layer == 0 ? 0 : 2);
#endif
            }
            GRID_BAR();
            { const Params p = ldp(); const int tid = otid(wv); fft_prepass(p, shm, c, G, tid); }
#ifndef SKIP_DFTP
            { const Params p = ldp(); const int tid = otid(wv); (void)tid; unsigned char* ws = p.ws; DftPSched S{(const char*)(ws + WS_D256), (const char*)(ws + F_HTP), G, c}; EpiDft E{(bf16_t*)(ws + F_HCS), 1};
              pg8::gemm_phase(lds, 256, 256, 256, S, E, wv); }
#endif
#ifndef SKIP_WP
            { const Params p = ldp(); const int tid = otid(wv); (void)tid; unsigned char* ws = p.ws; WpSched S{(const char*)(ws + WS_DC256), (const char*)(ws + WS_WUB), G, c}; EpiWp E{(bf16_t*)(ws + WS_WPQ)};
              pg8::gemm_phase(lds, 256, 256, 2048, S, E, wv); }
#endif
            GRID_BAR();
            { const Params p = ldp(); const int tid = otid(wv); (void)tid; unsigned char* ws = p.ws; Dft2Sched S{(const char*)(ws + WS_DF512), (const char*)(ws + F_Y), G, c}; EpiDft2 E{(bf16_t*)(ws + F_HCS)};
              pg8::gemm_phase(lds, 512, 512, 512, S, E, wv); }
            GRID_BAR();
#ifndef SKIP_FG
            { const Params p = ldp(); const int tid = otid(wv); (void)tid; unsigned char* ws = p.ws; RowSched S{(const char*)(ws + F_H), (const char*)(ws + WS_WG), (size_t)256 * 1024 * 2, (size_t)256 * 1024 * 2, 8, G, c}; EpiSiluStore E{(bf16_t*)(ws + F_G)};
              pg8::gemm_phase(lds, 1024, 1024, 1024, S, E, wv); }
#endif
#ifndef SKIP_FPQ
            { const Params p = ldp(); const int tid = otid(wv); (void)tid; unsigned char* ws = p.ws; RowSched S{(const char*)(ws + F_HCS), (const char*)(ws + WS_WPQ), (size_t)256 * 2048 * 2, (size_t)256 * 2048 * 2, 8, G, c}; EpiMulInplace E{(bf16_t*)(ws + F_G)};
              pg8::gemm_phase(lds, 2048, 2048, 2048, S, E, wv); }
#endif
            GRID_BAR();
#ifndef SKIP_FOUT
            { const Params p = ldp(); const int tid = otid(wv); (void)tid; unsigned char* ws = p.ws;
              const float* xp = layer == 0 ? p.x_prompt : p.out; const float* xs = layer == 0 ? p.x_sample : p.out + (size_t)TP * 1024;
              const size_t wo = WS_WOUT + (size_t)(layer & 1) * 4 * MiB, wo_next = WS_WOUT + (size_t)((layer + 1) & 1) * 4 * MiB;
              EpiOut E{xp, xs, p.out, (const float*)(ws + WS_MOD) + (size_t)layer * 9 * 3072};
              { RowSchedLim S{(const char*)(ws + F_G), (const char*)(ws + wo), (size_t)256 * 2048 * 2, (size_t)256 * 2048 * 2, 4, G, c, 64};
                pg8::gemm_phase(lds, 2048, 2048, 2048, S, E, wv); }
              GRID_BAR();
              int cq = c; asm volatile("" : "+s"(cq));
              if ((cq >> 3) < 8) { RowSchedTail S{(const char*)(ws + F_G), (const char*)(ws + wo), (size_t)256 * 2048 * 2, (size_t)256 * 2048 * 2, c};
                pg8::gemm_phase(lds, 2048, 2048, 2048, S, E, wv); }
              else {
                cvt_weights_attn(p, layer >> 1, shm, ((c >> 3) - 8) * 8 + (c & 7), 192, tid, wo_next); __syncthreads();
                norm_phase<false>(p, layer + 1, p.out, p.out + (size_t)TP * 1024, (bf16_t*)(ws + A_H), nullptr, nullptr, shm, c, G, tid, 1); } }
#endif
            GRID_BAR();
        } else {
            const int j = layer >> 1;
            { const Params p = ldp(); const int tid = otid(wv); (void)tid; unsigned char* ws = p.ws;
#ifndef SKIP_CVTA
#endif
#ifndef SKIP_NORMA
              norm_phase<false>(p, layer, p.out, p.out + (size_t)TP * 1024, (bf16_t*)(ws + A_H), nullptr, nullptr, shm, c, G, tid, 2);
#endif
            }
            GRID_BAR();
#pragma nounroll
            for (int hh = 0; hh < 2; ++hh) {
                { const Params p = ldp(); const int tid = otid(wv); (void)tid; unsigned char* ws = p.ws;
#ifndef SKIP_CACHE
                  cvt_cache(p, j, hh, c, G, tid);
#endif
#ifndef SKIP_AIN
                  RowSched S{(const char*)(ws + A_H), (const char*)(ws + WS_WATT) + (size_t)hh * 3072 * 1024 * 2, (size_t)256 * 1024 * 2, (size_t)256 * 1024 * 2, 12, G, c};
                  EpiAttnIn E{(bf16_t*)(ws + A_Q), (bf16_t*)(ws + A_K), (bf16_t*)(ws + A_V), p.out + (size_t)TT * 1024, p.out + (size_t)TT * 1024 + (size_t)16 * 2 * 256 * 2048,
                              (const float*)(ws + WS_COS), (const float*)(ws + WS_SIN), hh, j};
                  pg8::gemm_phase(lds, 1024, 1024, 1024, S, E, wv);
#endif
                }
                GRID_BAR();
#ifndef SKIP_ATT
                { const Params p = ldp(); const int tid = otid(wv); (void)tid; attn_phase(p, j, hh, shm, c, G, wv); }
#endif
                if (hh == 1) {
                    const Params p = ldp(); unsigned char* ws = p.ws; const float lam_init = 0.8f - 0.6f * expf(-0.3f * (float)layer);
                    __syncthreads();
                    CombEarlySched S{(const char*)(ws + A_H), (const char*)(ws + WS_WATT) + (size_t)6144 * 1024 * 2, (size_t)256 * 1024 * 2, (size_t)256 * 1024 * 2, c};
                    EpiCombine E{(bf16_t*)(ws + A_DIFF), (const float*)(ws + A_SSQ), p.subln_g + j * 256, 1.f - lam_init};
                    pg8::gemm_phase(lds, 1024, 1024, 1024, S, E, wv);
                }
                GRID_BAR();
            }
#ifndef SKIP_COMB
            { const Params p = ldp(); const int tid = otid(wv); (void)tid; unsigned char* ws = p.ws; const float lam_init = 0.8f - 0.6f * expf(-0.3f * (float)layer);
              CombLateSched S{(const char*)(ws + A_H), (const char*)(ws + WS_WATT) + (size_t)6144 * 1024 * 2, (size_t)256 * 1024 * 2, (size_t)256 * 1024 * 2, c};
              EpiCombine E{(bf16_t*)(ws + A_DIFF), (const float*)(ws + A_SSQ), p.subln_g + j * 256, 1.f - lam_init};
              pg8::gemm_phase(lds, 1024, 1024, 1024, S, E, wv); }
#endif
            GRID_BAR();
#ifndef SKIP_AOUT
            { const Params p = ldp(); const int tid = otid(wv); (void)tid; unsigned char* ws = p.ws;
              const size_t wo = WS_WOUT + (size_t)(layer & 1) * 4 * MiB, wo_next = WS_WOUT + (size_t)((layer + 1) & 1) * 4 * MiB;
              EpiOut E{p.out, p.out + (size_t)TP * 1024, p.out, (const float*)(ws + WS_MOD) + (size_t)layer * 9 * 3072};
              { RowSchedLim S{(const char*)(ws + A_DIFF), (const char*)(ws + wo), (size_t)256 * 2048 * 2, (size_t)256 * 2048 * 2, 4, G, c, 64};
                pg8::gemm_phase(lds, 2048, 2048, 2048, S, E, wv); }
              GRID_BAR();
              int cq = c; asm volatile("" : "+s"(cq));
              if ((cq >> 3) < 8) { RowSchedTail S{(const char*)(ws + A_DIFF), (const char*)(ws + wo), (size_t)256 * 2048 * 2, (size_t)256 * 2048 * 2, c};
                pg8::gemm_phase(lds, 2048, 2048, 2048, S, E, wv); }
              else if (layer + 1 < 4) {
                cvt_weights_fourier(p, (layer + 1) >> 1, shm, ((c >> 3) - 8) * 8 + (c & 7), 192, tid, wo_next); __syncthreads();
                norm_phase<true>(p, layer + 1, p.out, p.out + (size_t)TP * 1024, (bf16_t*)(ws + F_H), (bf16_t*)(ws + F_HTP), nullptr, shm, c, G, tid, 1); }
              else final_norm(p, c, G, tid, 1); }
#endif
            GRID_BAR();
        }
    }
#ifndef SKIP_FIN
    { const Params p = ldp(); const int tid = otid(wv); (void)tid; final_norm(p, c, G, tid, 2); }
#endif
}

extern "C" void kernel_launch(void* const* d_in, const int* in_sizes, int n_in, void* d_out, int out_size, void* d_ws, size_t ws_size, hipStream_t stream) {
    static int grid_blocks = 0;
    if (grid_blocks == 0) {
        if (n_in != 19 || ws_size < WS_NEED) { fprintf(stderr, "kernel_launch: need 19 inputs and %zu bytes of workspace (got %d, %zu)\n", (size_t)WS_NEED, n_in, ws_size); grid_blocks = -1; return; }
        int dev = 0, cus = 0, per_cu = 0;
        hipGetDevice(&dev);
        hipDeviceGetAttribute(&cus, hipDeviceAttributeMultiprocessorCount, dev);
        if (hipFuncSetAttribute((const void*)mega_fwd, hipFuncAttributeMaxDynamicSharedMemorySize, LDS_BYTES) != hipSuccess) { fprintf(stderr, "kernel_launch: hipFuncSetAttribute failed\n"); grid_blocks = -1; return; }
        if (hipOccupancyMaxActiveBlocksPerMultiprocessor(&per_cu, (const void*)mega_fwd, NTHREADS, LDS_BYTES) != hipSuccess || per_cu < 1) { fprintf(stderr, "kernel_launch: occupancy query gives %d\n", per_cu); per_cu = 1; }
        (void)hipGetLastError();
        grid_blocks = cus;
        if (grid_blocks != 256) { fprintf(stderr, "kernel_launch: built for a 256-CU device (got %d CUs)\n", grid_blocks); grid_blocks = -1; return; }
    }
    if (grid_blocks < 0) return;
    Params p{};
    p.x_prompt = (const float*)d_in[0]; p.x_sample = (const float*)d_in[1]; p.cache_k = (const float*)d_in[2]; p.cache_v = (const float*)d_in[3];
    p.c = (const float*)d_in[4]; p.c_ctx = (const float*)d_in[5]; p.norm_g = (const float*)d_in[6]; p.w_ada = (const float*)d_in[7]; p.b_ada = (const float*)d_in[8];
    p.w_in_f = (const float*)d_in[9]; p.w_out_f = (const float*)d_in[10]; p.w_in_a = (const float*)d_in[11]; p.w_out_a = (const float*)d_in[12];
    p.lam_q1 = (const float*)d_in[13]; p.lam_k1 = (const float*)d_in[14]; p.lam_q2 = (const float*)d_in[15]; p.lam_k2 = (const float*)d_in[16];
    p.subln_g = (const float*)d_in[17]; p.final_g = (const float*)d_in[18];
    p.out = (float*)d_out; p.ws = (unsigned char*)d_ws;
    (void)hipMemsetAsync((char*)d_ws + WS_XBAR, 0, XCD_BAR_WORDS * 4, stream);
    void* args[] = {&p};
    hipError_t e = hipLaunchCooperativeKernel((const void*)mega_fwd, dim3(grid_blocks), dim3(NTHREADS), args, LDS_BYTES, stream);
    if (e != hipSuccess) fprintf(stderr, "cooperative launch failed: %s (grid %d)\n", hipGetErrorString(e), grid_blocks);
}
```
